# Optimizing an MI355X kernel written in HIP

```python
import math
import jax, jax.numpy as jnp
from jax import lax
import numpy as np

D_MODEL = 2048
BATCH = 4
SEQ = 2048
DEPTH = 1
DEC_BATCH = 128
DEC_SEQ = 1
PAST_LEN = 16384
PAGE_SIZE = 128

D_MIX = D_MODEL
D_RWKV = D_MIX // 2
D_CONV = D_MIX - D_RWKV
HEAD_DIM = 64
N_HEADS_RWKV = D_RWKV // HEAD_DIM
CONV_GROUP = 64
N_CONV_GROUPS = D_CONV // CONV_GROUP
DECAY_LORA = 64
ICLR_LORA = 64
GATE_LORA = 160
CONV_WIDTH = 31
N_MEM = 256
N_MEM_HEADS = 4
MEM_HEAD_DIM = D_MODEL // N_MEM_HEADS
D_FF = 5632
ALPHA = (2.0 * DEPTH) ** 0.25
BETA = (8.0 * DEPTH) ** -0.25
LN_EPS = 1e-5
GN_EPS = 64e-5
SHIFT_COLS = 3 * D_RWKV + DECAY_LORA + ICLR_LORA + GATE_LORA
IN_COLS = SHIFT_COLS + 2 * D_CONV
SPLITS = [D_RWKV, 2 * D_RWKV, 3 * D_RWKV, 3 * D_RWKV + DECAY_LORA, 3 * D_RWKV + DECAY_LORA + ICLR_LORA]

kernel_name = "hymba_rwkv7_conformer_macaron_deepnorm_step"


def layer_norm(x, g, b, eps=LN_EPS):
    xf = x.astype(jnp.float32)
    mu = jnp.mean(xf, axis=-1, keepdims=True)
    var = jnp.mean(jnp.square(xf - mu), axis=-1, keepdims=True)
    return ((xf - mu) * lax.rsqrt(var + eps) * g.astype(jnp.float32) + b.astype(jnp.float32)).astype(x.dtype)


def swiglu(x, w1, w3, w2):
    return (jax.nn.silu(x @ w1) * (x @ w3)) @ w2


def rwkv7_recurrence(state, r, decay, k, v, kk, a):
    def step(S, inp):
        r_t, w_t, k_t, v_t, kk_t, a_t = inp
        sa = jnp.einsum('bhvk,bhk->bhv', S, -kk_t)
        S = (S * w_t[:, :, None, :]
             + sa[..., None] * (kk_t * a_t)[:, :, None, :]
             + v_t[..., None] * k_t[:, :, None, :])
        y_t = jnp.einsum('bhvk,bhk->bhv', S, r_t)
        return S, y_t
    xs = tuple(jnp.swapaxes(t, 0, 1) for t in (r, decay, k, v, kk, a))
    S, ys = lax.scan(step, state, xs)
    return jnp.swapaxes(ys, 0, 1), S


def parallel_mixer(h, shift_prev, conv_prev, wkv_prev, p):
    B, T, _ = h.shape
    dt = h.dtype
    f32 = jnp.float32
    proj = h @ p['w_in']
    ps, pc = proj[..., :SHIFT_COLS], proj[..., SHIFT_COLS:]
    ps_prev = jnp.concatenate([shift_prev[:, None, :].astype(dt), ps[:, :-1]], axis=1)
    pm = ps + p['mu_shift'] * (ps_prev - ps)
    r, k, v, wd, ad, gd = jnp.split(pm, SPLITS, axis=-1)

    w_log = -jax.nn.softplus(-(p['w0'] + jnp.tanh(wd) @ p['w2_decay']).astype(f32)) - 0.5
    decay = jnp.exp(-jnp.exp(w_log))
    a = jax.nn.sigmoid((p['a0'] + ad @ p['a2_iclr']).astype(f32))
    g = (jax.nn.sigmoid(gd) @ p['g2_gate']).astype(f32)
    rf, kf, vf = r.astype(f32), k.astype(f32), v.astype(f32)
    kk = (kf * p['k_k'].astype(f32)).reshape(B, T, N_HEADS_RWKV, HEAD_DIM)
    kk = kk / jnp.maximum(jnp.linalg.norm(kk, axis=-1, keepdims=True), 1e-12)
    kf = kf * (1.0 + (a - 1.0) * p['k_a'].astype(f32))
    hd = lambda t: t.reshape(B, T, N_HEADS_RWKV, HEAD_DIM)
    rh, kh, vh, wh, ah = hd(rf), hd(kf), hd(vf), hd(decay), hd(a)
    y, wkv_new = rwkv7_recurrence(wkv_prev.astype(f32), rh, wh, kh, vh, kk, ah)
    mu = jnp.mean(y, axis=-1, keepdims=True)
    var = jnp.mean(jnp.square(y - mu), axis=-1, keepdims=True)
    yn = ((y - mu) * lax.rsqrt(var + GN_EPS)).reshape(B, T, D_RWKV)
    yn = yn * p['gn_g'].astype(f32) + p['gn_b'].astype(f32)
    bonus = (jnp.sum(rh * kh * p['r_k'].astype(f32), axis=-1, keepdims=True) * vh).reshape(B, T, D_RWKV)
    o_a = ((yn + bonus) * g).astype(dt)

    u = pc[..., :D_CONV] * jax.nn.sigmoid(pc[..., D_CONV:])
    ubuf = jnp.concatenate([conv_prev.astype(dt), u], axis=1)
    c = lax.conv_general_dilated(ubuf, p['conv_w'], window_strides=(1,), padding='VALID',
                                 dimension_numbers=('NWC', 'WIO', 'NWC'),
                                 feature_group_count=D_CONV) + p['conv_b']
    o_b = jax.nn.silu(layer_norm(c, p['conv_ln_g'], p['conv_ln_b']))

    merged = jnp.concatenate([o_a * p['beta_rwkv'], o_b * p['beta_conv']], axis=-1) @ p['w_out']
    return merged, ps[:, -1], ubuf[:, -(CONV_WIDTH - 1):], wkv_new


def mem_kv(mem, w_mk, w_mv):
    B = mem.shape[0]
    mk = (mem @ w_mk).reshape(B, N_MEM, N_MEM_HEADS, MEM_HEAD_DIM)
    mv = (mem @ w_mv).reshape(B, N_MEM, N_MEM_HEADS, MEM_HEAD_DIM)
    return mk, mv


def mem_attend(h, mk, mv, w_mq, w_mo):
    B, T, _ = h.shape
    q = (h @ w_mq).reshape(B, T, N_MEM_HEADS, MEM_HEAD_DIM)
    s = jnp.einsum('bthd,bshd->bhts', q, mk.astype(h.dtype)).astype(jnp.float32) / math.sqrt(MEM_HEAD_DIM)
    pr = jax.nn.softmax(s, axis=-1).astype(h.dtype)
    o = jnp.einsum('bhts,bshd->bthd', pr, mv.astype(h.dtype)).reshape(B, T, D_MODEL)
    return o @ w_mo


def trunk_layer(x, shift_prev, conv_prev, wkv_prev, mk, mv, p):
    x = layer_norm(ALPHA * x + 0.5 * swiglu(x, p['ffn1_w1'], p['ffn1_w3'], p['ffn1_w2']), p['ln1_g'], p['ln1_b'])
    mix, sh, cv, wkv = parallel_mixer(x, shift_prev, conv_prev, wkv_prev, p)
    x = layer_norm(ALPHA * x + mix, p['ln2_g'], p['ln2_b'])
    x = layer_norm(ALPHA * x + mem_attend(x, mk, mv, p['w_mq'], p['w_mo']), p['ln3_g'], p['ln3_b'])
    x = layer_norm(ALPHA * x + 0.5 * swiglu(x, p['ffn2_w1'], p['ffn2_w3'], p['ffn2_w2']), p['ln4_g'], p['ln4_b'])
    return x, sh, cv, wkv


def setup_inputs(seed: int = 0) -> dict:
    key = jax.random.key(seed)
    ks = iter(jax.random.split(key, 64))
    nrm = lambda shape, s=1.0: jax.random.normal(next(ks), shape, jnp.float32) * s
    gain = lambda n: 1.0 + nrm((DEPTH, n), 0.02)
    bias = lambda n: nrm((DEPTH, n), 0.02)
    L = DEPTH
    d = {}
    d['x_prompt'] = nrm((BATCH, SEQ, D_MODEL))
    d['x_sample'] = nrm((DEC_BATCH, DEC_SEQ, D_MODEL))
    d['mem_prompt'] = nrm((BATCH, N_MEM, D_MODEL))
    d['state_shift'] = nrm((L, DEC_BATCH, SHIFT_COLS))
    d['state_conv'] = nrm((L, DEC_BATCH, CONV_WIDTH - 1, D_CONV), 0.5)
    d['state_wkv'] = nrm((L, DEC_BATCH, N_HEADS_RWKV, HEAD_DIM, HEAD_DIM), 0.5)
    d['cache_mem_k'] = nrm((L, DEC_BATCH, N_MEM, N_MEM_HEADS, MEM_HEAD_DIM))
    d['cache_mem_v'] = nrm((L, DEC_BATCH, N_MEM, N_MEM_HEADS, MEM_HEAD_DIM))
    d['ffn1_w1'] = nrm((L, D_MODEL, D_FF), D_MODEL ** -0.5)
    d['ffn1_w3'] = nrm((L, D_MODEL, D_FF), D_MODEL ** -0.5)
    d['ffn1_w2'] = nrm((L, D_FF, D_MODEL), BETA * D_FF ** -0.5)
    d['ln1_g'] = gain(D_MODEL)
    d['ln1_b'] = bias(D_MODEL)
    d['w_in'] = nrm((L, D_MODEL, IN_COLS), D_MODEL ** -0.5)
    d['mu_shift'] = jax.random.uniform(next(ks), (L, SHIFT_COLS), jnp.float32)
    d['w0'] = jax.random.uniform(next(ks), (L, D_RWKV), jnp.float32, -6.0, -0.5)
    d['w2_decay'] = nrm((L, DECAY_LORA, D_RWKV), 0.1 * DECAY_LORA ** -0.5)
    d['a0'] = nrm((L, D_RWKV), 0.1)
    d['a2_iclr'] = nrm((L, ICLR_LORA, D_RWKV), 0.5 * ICLR_LORA ** -0.5)
    d['g2_gate'] = nrm((L, GATE_LORA, D_RWKV), GATE_LORA ** -0.5)
    d['k_k'] = 0.85 + nrm((L, D_RWKV), 0.05)
    d['k_a'] = 1.0 + nrm((L, D_RWKV), 0.05)
    d['r_k'] = nrm((L, N_HEADS_RWKV, HEAD_DIM), 0.1)
    d['gn_g'] = gain(D_RWKV)
    d['gn_b'] = bias(D_RWKV)
    d['conv_w'] = nrm((L, CONV_WIDTH, 1, D_CONV), CONV_WIDTH ** -0.5)
    d['conv_b'] = bias(D_CONV)
    d['conv_ln_g'] = gain(D_CONV)
    d['conv_ln_b'] = bias(D_CONV)
    d['beta_rwkv'] = gain(D_RWKV)
    d['beta_conv'] = gain(D_CONV)
    d['w_out'] = nrm((L, D_MIX, D_MODEL), BETA * D_MIX ** -0.5)
    d['ln2_g'] = gain(D_MODEL)
    d['ln2_b'] = bias(D_MODEL)
    d['w_mq'] = nrm((L, D_MODEL, D_MODEL), D_MODEL ** -0.5)
    d['w_mk'] = nrm((L, D_MODEL, D_MODEL), D_MODEL ** -0.5)
    d['w_mv'] = nrm((L, D_MODEL, D_MODEL), D_MODEL ** -0.5)
    d['w_mo'] = nrm((L, D_MODEL, D_MODEL), BETA * D_MODEL ** -0.5)
    d['ln3_g'] = gain(D_MODEL)
    d['ln3_b'] = bias(D_MODEL)
    d['ffn2_w1'] = nrm((L, D_MODEL, D_FF), D_MODEL ** -0.5)
    d['ffn2_w3'] = nrm((L, D_MODEL, D_FF), D_MODEL ** -0.5)
    d['ffn2_w2'] = nrm((L, D_FF, D_MODEL), BETA * D_FF ** -0.5)
    d['ln4_g'] = gain(D_MODEL)
    d['ln4_b'] = bias(D_MODEL)
    return d


def reference(x_prompt, x_sample, mem_prompt, state_shift, state_conv, state_wkv, cache_mem_k, cache_mem_v,
              ffn1_w1, ffn1_w3, ffn1_w2, ln1_g, ln1_b, w_in, mu_shift, w0, w2_decay, a0, a2_iclr, g2_gate,
              k_k, k_a, r_k, gn_g, gn_b, conv_w, conv_b, conv_ln_g, conv_ln_b, beta_rwkv, beta_conv, w_out,
              ln2_g, ln2_b, w_mq, w_mk, w_mv, w_mo, ln3_g, ln3_b, ffn2_w1, ffn2_w3, ffn2_w2, ln4_g, ln4_b):
    B = x_prompt.shape[0]
    dt = x_prompt.dtype
    hp, hs = x_prompt, x_sample
    sh_p_all, cv_p_all, wkv_p_all, mk_p_all, mv_p_all = [], [], [], [], []
    sh_s_all, cv_s_all, wkv_s_all = [], [], []
    for l in range(DEPTH):
        p = dict(ffn1_w1=ffn1_w1[l], ffn1_w3=ffn1_w3[l], ffn1_w2=ffn1_w2[l], ln1_g=ln1_g[l], ln1_b=ln1_b[l],
                 w_in=w_in[l], mu_shift=mu_shift[l], w0=w0[l], w2_decay=w2_decay[l], a0=a0[l],
                 a2_iclr=a2_iclr[l], g2_gate=g2_gate[l], k_k=k_k[l], k_a=k_a[l], r_k=r_k[l],
                 gn_g=gn_g[l], gn_b=gn_b[l], conv_w=conv_w[l], conv_b=conv_b[l], conv_ln_g=conv_ln_g[l],
                 conv_ln_b=conv_ln_b[l], beta_rwkv=beta_rwkv[l], beta_conv=beta_conv[l], w_out=w_out[l],
                 ln2_g=ln2_g[l], ln2_b=ln2_b[l], w_mq=w_mq[l], w_mo=w_mo[l], ln3_g=ln3_g[l], ln3_b=ln3_b[l],
                 ffn2_w1=ffn2_w1[l], ffn2_w3=ffn2_w3[l], ffn2_w2=ffn2_w2[l], ln4_g=ln4_g[l], ln4_b=ln4_b[l])
        mk_p, mv_p = mem_kv(mem_prompt, w_mk[l], w_mv[l])
        hp, sh_p, cv_p, wkv_p = trunk_layer(
            hp, jnp.zeros((B, SHIFT_COLS), dt), jnp.zeros((B, CONV_WIDTH - 1, D_CONV), dt),
            jnp.zeros((B, N_HEADS_RWKV, HEAD_DIM, HEAD_DIM), jnp.float32), mk_p, mv_p, p)
        hs, sh_s, cv_s, wkv_s = trunk_layer(
            hs, state_shift[l], state_conv[l], state_wkv[l], cache_mem_k[l], cache_mem_v[l], p)
        sh_p_all.append(sh_p); cv_p_all.append(cv_p); wkv_p_all.append(wkv_p)
        mk_p_all.append(mk_p); mv_p_all.append(mv_p)
        sh_s_all.append(sh_s); cv_s_all.append(cv_s); wkv_s_all.append(wkv_s)
    return (hp, hs,
            jnp.stack(sh_p_all), jnp.stack(cv_p_all), jnp.stack(wkv_p_all),
            jnp.stack(mk_p_all), jnp.stack(mv_p_all),
            jnp.stack(sh_s_all), jnp.stack(cv_s_all), jnp.stack(wkv_s_all))
```

```cpp
#ifndef DUPMASK
#define DUPMASK 0
#endif
#include <hip/hip_runtime.h>
#include <hip/hip_cooperative_groups.h>
#include <cstdio>
#include <cstdint>
namespace cg = cooperative_groups;

#define LAS __attribute__((address_space(3)))
typedef unsigned short bf16_t;
typedef short bf16x8 __attribute__((ext_vector_type(8)));
typedef float f32x4 __attribute__((ext_vector_type(4)));
typedef float f32x2 __attribute__((ext_vector_type(2)));
typedef unsigned u32x4 __attribute__((ext_vector_type(4)));
typedef unsigned u32x2 __attribute__((ext_vector_type(2)));

constexpr int D = 2048, MP = 8192, MS = 128, M = MP + MS, MPAD = 8448, SEQ = 2048, NB = 4;
constexpr int FF = 5632, SC = 3360, DR = 1024, DC = 1024, NH = 16, HD = 64;
constexpr int NMEM = 256, NMH = 4, MHD = 512, CW = 31, LK = 384;
constexpr float ALPHA = 1.189207115002721f;
constexpr float LN_EPS = 1e-5f, GN_EPS = 64e-5f;
constexpr float QSCALE = 0.044194173824159216f;

enum { I_XP = 0, I_XS, I_MEM, I_SSH, I_SCV, I_SWKV, I_CK, I_CV, I_F1W1, I_F1W3, I_F1W2, I_LN1G, I_LN1B, I_WIN, I_MU, I_W0, I_W2D, I_A0, I_A2, I_G2,
       I_KK, I_KA, I_RK, I_GNG, I_GNB, I_CVW, I_CVB, I_CLG, I_CLB, I_BR, I_BC, I_WOUT, I_LN2G, I_LN2B, I_WMQ, I_WMK, I_WMV, I_WMO, I_LN3G, I_LN3B,
       I_F2W1, I_F2W3, I_F2W2, I_LN4G, I_LN4B, N_IN };
constexpr size_t O_Y = 0, O_SHP = (size_t)M * D, O_CVP = O_SHP + (size_t)NB * SC, O_WKP = O_CVP + (size_t)NB * 30 * DC, O_MKP = O_WKP + (size_t)NB * NH * HD * HD,
                 O_MVP = O_MKP + (size_t)NB * NMEM * D, O_SHS = O_MVP + (size_t)NB * NMEM * D, O_CVS = O_SHS + (size_t)MS * SC, O_WKS = O_CVS + (size_t)MS * 30 * DC,
                 O_END = O_WKS + (size_t)MS * NH * HD * HD;
constexpr size_t MiB = 1u << 20;
constexpr size_t WS_W13A = 0, WS_W2A = WS_W13A + 44 * MiB, WS_WIN = WS_W2A + 22 * MiB, WS_WOUT = WS_WIN + 22 * MiB, WS_WMQ = WS_WOUT + 8 * MiB, WS_WMK = WS_WMQ + 8 * MiB,
                 WS_WMV = WS_WMK + 8 * MiB, WS_WMO = WS_WMV + 8 * MiB, WS_W13B = WS_WMO + 8 * MiB, WS_W2B = WS_W13B + 44 * MiB, WS_WLORA = WS_W2B + 22 * MiB,
                 WS_XB = WS_WLORA + 3 * MiB,
                 WS_Z = WS_XB + 33 * MiB,
                 WS_XF = WS_Z + 65 * MiB,
                 WS_RA = WS_XF + 65 * MiB,
                 WS_RB = WS_RA + 107 * MiB,
                 WS_RKV = WS_RB + 98 * MiB,
                 WS_U = WS_RKV + 98 * MiB,
                 WS_LA = WS_U + 33 * MiB,
                 WS_OMIX = WS_LA + 7 * MiB,
                 WS_MEMB = WS_OMIX + 33 * MiB,
                 WS_KB = WS_MEMB + 4 * MiB,
                 WS_VT = WS_KB + 4 * MiB,
                 WS_PART = WS_VT + 4 * MiB,
                 WS_CTL = WS_PART + 23 * MiB,
                 WS_END = WS_CTL + 1 * MiB;
constexpr size_t WS_Y = WS_RKV;
constexpr size_t WS_Q = WS_RA, WS_P = WS_RA + 33 * MiB, WS_OA = WS_RA + 50 * MiB;

constexpr int LDS_BYTES = 131072 + 2048;
constexpr int NPHASE = 19;

struct Params { const float* in[N_IN]; float* out; unsigned char* ws; int ph_lo, ph_hi; };

__device__ __forceinline__ unsigned cvt_pk_bf16(float lo, float hi) { unsigned r; asm("v_cvt_pk_bf16_f32 %0, %1, %2" : "=v"(r) : "v"(lo), "v"(hi)); return r; }
__device__ __forceinline__ bf16_t f2bf(float f) { return (bf16_t)(cvt_pk_bf16(f, f) & 0xffffu); }
__device__ __forceinline__ float bf2f(bf16_t b) { return __builtin_bit_cast(float, (unsigned)b << 16); }
template <int C> __device__ __forceinline__ float dppf(float v) { return __builtin_bit_cast(float, __builtin_amdgcn_update_dpp(0, __builtin_bit_cast(int, v), C, 0xF, 0xF, true)); }
__device__ __forceinline__ float red8(float x) { x += dppf<0xB1>(x); x += dppf<0x4E>(x); x += dppf<0x141>(x); return x; }
__device__ __forceinline__ float red16(float x) { x += dppf<0xB1>(x); x += dppf<0x4E>(x); x += dppf<0x141>(x); x += dppf<0x140>(x); return x; }
__device__ __forceinline__ float swap16_sum(float x) { float a = x, b = x; asm volatile("s_nop 1\n\tv_permlane16_swap_b32 %0, %1" : "+v"(a), "+v"(b)); return a + b; }
__device__ __forceinline__ float swap32_sum(float x) { float a = x, b = x; asm volatile("s_nop 1\n\tv_permlane32_swap_b32 %0, %1" : "+v"(a), "+v"(b)); return a + b; }
__device__ __forceinline__ float wave_sum(float v) { return swap32_sum(swap16_sum(red16(v))); }
__device__ __forceinline__ float wave_max(float v) {
#pragma unroll
    for (int o = 1; o < 64; o <<= 1) v = fmaxf(v, __shfl_xor(v, o));
    return v;
}
__device__ __forceinline__ float sigmoid_f(float x) { return __builtin_amdgcn_rcpf(1.f + __expf(-x)); }
__device__ __forceinline__ float silu_f(float x) { return x * __builtin_amdgcn_rcpf(1.f + __expf(-x)); }

constexpr int BK = 64, HALF = 128, HTB = HALF * BK * 2;
__device__ __forceinline__ int lds_byte(int r, int c) { const int st = (r >> 4) * 2 + (c >> 5), rr = r & 15, cc = c & 31, ob = rr * 64 + cc * 2; return st * 1024 + (ob ^ (((ob >> 9) & 1) << 5)); }
__device__ __forceinline__ void stage_rc(int b, int& R, int& C) { const int st = b / 1024, sb = b % 1024, swz = sb ^ (((sb >> 9) & 1) << 5); R = (st >> 1) * 16 + swz / 64; C = (st & 1) * 32 + (swz % 64) / 2; }
__device__ __forceinline__ int perm32(int rho) { const int n = rho >> 4, i = rho & 15; return 8 * (i >> 2) + 4 * n + (i & 3); }

struct Unit { const char* A; const char* B; int r0, c0, tn; };
typedef f32x4 Acc[2][2][4][2];

struct SchedPlain {
    const char* A; const char* B; int lda, ldb, nM, nN, nwg, G, c;
    __device__ __forceinline__ void init(const void* A_, const void* B_, int lda_, int ldb_, int nM_, int nN_, int G_, int c_) { A = (const char*)A_; B = (const char*)B_; lda = lda_; ldb = ldb_; nM = nM_; nN = nN_; nwg = nM_ * nN_; G = G_; c = c_; }
    __device__ __forceinline__ bool next(int i, Unit& u) const {
        const long L = (long)i * G + c; if (L >= nwg) return false;
        int wgid = (int)L; { const int q = nwg / 8, r = nwg % 8, xcd = wgid % 8, off = wgid / 8; wgid = (xcd < r ? xcd * (q + 1) : r * (q + 1) + (xcd - r) * q) + off; }
        const int nig = 8 * nN, gid = wgid / nig, fm = gid * 8, gsz = (nM - fm) < 8 ? (nM - fm) : 8;
        const int pm = fm + ((wgid % nig) % gsz), pn = (wgid % nig) / gsz;
        u.A = A + (size_t)pm * 256 * lda * 2; u.B = B + (size_t)pn * 256 * ldb * 2; u.r0 = pm * 256; u.c0 = pn * 256; u.tn = pn; return true;
    }
};
struct SchedScores {
    const char* Q; const char* KB; int G, c;
    __device__ __forceinline__ bool next(int i, Unit& u) const {
        const long L = (long)i * G + c; if (L >= 128) return false;
        const int z = (int)L >> 3, pm = (int)L & 7, b = z >> 2, h = z & 3;
        u.A = Q + ((size_t)(b * SEQ + pm * 256) * D + h * MHD) * 2; u.B = KB + ((size_t)(b * NMEM) * D + h * MHD) * 2; u.r0 = b * SEQ + pm * 256; u.c0 = h * NMEM; u.tn = 0; return true;
    }
};
struct SchedPV {
    const char* P; const char* VT; int G, c;
    __device__ __forceinline__ bool next(int i, Unit& u) const {
        const long L = (long)i * G + c; if (L >= 256) return false;
        const int z = (int)L >> 4, pm = ((int)L & 15) >> 1, pn = (int)L & 1, b = z >> 2, h = z & 3;
        u.A = P + ((size_t)(b * SEQ + pm * 256) * 1024 + h * NMEM) * 2; u.B = VT + ((size_t)(b * D + h * MHD + pn * 256) * NMEM) * 2; u.r0 = b * SEQ + pm * 256; u.c0 = h * MHD + pn * 256; u.tn = pn; return true;
    }
};

struct SchedPieces {
    const char* A; const char* B; int lda, ldb, total, G, c;
    __device__ __forceinline__ bool next(int i, Unit& u) const {
        const long L = (long)i * G + c; if (L >= total) return false;
        const int pn = (int)L & 7, sl = (int)L >> 3;
        u.A = A + ((size_t)MP * lda + sl * 256) * 2; u.B = B + ((size_t)pn * 256 * ldb + sl * 256) * 2; u.r0 = MP; u.c0 = pn * 256; u.tn = sl; return true;
    }
};

template <class Epi, class Sched>
__device__ __forceinline__ void gemm_phase(LAS unsigned char* lds, const int lda, const int ldb, const int K, const Sched& S, const Epi& E) {
    const int tid = threadIdx.x, wid = __builtin_amdgcn_readfirstlane(tid >> 6), lane = tid & 63, wr = wid >> 2, wc = wid & 3, fr = lane & 15, fq = lane >> 4;
    const int nt = K / BK;
    unsigned voffA[2], voffB[2];
#pragma unroll
    for (int i = 0; i < 2; ++i) { int R, C; stage_rc(tid * 16 + i * 8192, R, C); const int Rb = (R & ~31) + perm32(R & 31);
        voffA[i] = (unsigned)(R * lda + C) * 2u; voffB[i] = (unsigned)(Rb * ldb + C) * 2u; }
    const size_t kstep = (size_t)(BK * 2);
    const size_t hstepA = (size_t)HALF * lda * 2, hstepB = (size_t)HALF * ldb * 2;
    const unsigned ldsw = (unsigned)wid * 1024u;
    const int aoff = lds_byte(wr * 64 + fr, fq * 8), boff = lds_byte(wc * 32 + fr, fq * 8);
#define G_SA(b, h) (((b) * 2 + (h)) * HTB)
#define G_SB(b, h) ((4 + (b) * 2 + (h)) * HTB)
#define G_STAGE(bufoff, gbase, voff) do { _Pragma("unroll") for (int _i = 0; _i < 2; ++_i) \
        __builtin_amdgcn_global_load_lds((const unsigned*)((const char*)(gbase) + (voff)[_i]), (LAS unsigned*)(lds + (bufoff) + ldsw + _i * 8192), 16, 0, 0); } while (0)
#define G_LDA(dst, b, h) do { _Pragma("unroll") for (int m = 0; m < 4; ++m) _Pragma("unroll") for (int k = 0; k < 2; ++k) dst[m][k] = *(const LAS bf16x8*)(lds + G_SA(b, h) + aoff + m * 2048 + k * 1024); } while (0)
#define G_LDB(dst, b, h) do { _Pragma("unroll") for (int n = 0; n < 2; ++n) _Pragma("unroll") for (int k = 0; k < 2; ++k) dst[n][k] = *(const LAS bf16x8*)(lds + G_SB(b, h) + boff + n * 2048 + k * 1024); } while (0)
#define G_MMA(ai, bj, At, Bt) do { __builtin_amdgcn_s_setprio(1); _Pragma("unroll") for (int m = 0; m < 4; ++m) _Pragma("unroll") for (int n = 0; n < 2; ++n) _Pragma("unroll") for (int k = 0; k < 2; ++k) \
        acc[ai][bj][m][n] = __builtin_amdgcn_mfma_f32_16x16x32_bf16(Bt[n][k], At[m][k], acc[ai][bj][m][n], 0, 0, 0); __builtin_amdgcn_s_setprio(0); } while (0)
#define G_WAIT_V(n) asm volatile("s_waitcnt vmcnt(" #n ")" ::: "memory")
#define G_WAIT_L(n) asm volatile("s_waitcnt lgkmcnt(" #n ")" ::: "memory")
#define G_BAR __builtin_amdgcn_s_barrier()
#define G_SCHED __builtin_amdgcn_sched_barrier(0)
    Unit cur, nxt; int ui = 0;
    if (!S.next(0, cur)) return;
    Acc acc;
#pragma unroll
    for (int a = 0; a < 2; ++a)
#pragma unroll
        for (int b = 0; b < 2; ++b)
#pragma unroll
            for (int m = 0; m < 4; ++m)
#pragma unroll
                for (int n = 0; n < 2; ++n) acc[a][b][m][n] = (f32x4){0.f, 0.f, 0.f, 0.f};
    bf16x8 At[4][2], B0[2][2], B1[2][2];
    const char* cA = cur.A; const char* cB = cur.B;
    G_STAGE(G_SB(0, 0), cB, voffB); G_STAGE(G_SB(0, 1), cB + hstepB, voffB); G_STAGE(G_SA(0, 0), cA, voffA); G_STAGE(G_SA(0, 1), cA + hstepA, voffA);
    if (wr == 1) G_BAR;
    G_WAIT_V(2); G_BAR;
    G_STAGE(G_SB(1, 0), cB + kstep, voffB); G_STAGE(G_SA(1, 0), cA + kstep, voffA); G_STAGE(G_SB(1, 1), cB + hstepB + kstep, voffB);
    G_WAIT_V(6); G_BAR;
    for (;;) {
        const bool has_next = S.next(ui + 1, nxt);
        const char* nA = has_next ? nxt.A : cA; const char* nB = has_next ? nxt.B : cB;
#pragma unroll 1
        for (int t = 0; t < nt; t += 2) {
            const bool last = (t == nt - 2);
            const char* a1 = cA + (size_t)(t + 1) * kstep;
            const char* a2 = last ? nA : cA + (size_t)(t + 2) * kstep; const char* b2 = last ? nB : cB + (size_t)(t + 2) * kstep;
            const char* a3 = a2 + kstep; const char* b3 = b2 + kstep;
            G_LDB(B0, 0, 0); G_LDB(B1, 0, 1); G_SCHED; G_LDA(At, 0, 0); G_STAGE(G_SA(1, 1), a1 + hstepA, voffA);
            G_WAIT_V(8); G_WAIT_L(0); G_BAR; G_MMA(0, 0, At, B0); G_MMA(0, 1, At, B1); G_BAR; G_SCHED;
            G_LDA(At, 0, 1); G_STAGE(G_SB(0, 0), b2, voffB); G_STAGE(G_SB(0, 1), b2 + hstepB, voffB); G_STAGE(G_SA(0, 0), a2, voffA);
            G_WAIT_V(8); G_WAIT_L(0); G_BAR; G_MMA(1, 0, At, B0); G_MMA(1, 1, At, B1); G_BAR; G_SCHED;
            G_LDB(B0, 1, 0); G_LDB(B1, 1, 1); G_SCHED; G_LDA(At, 1, 0); G_STAGE(G_SA(0, 1), a2 + hstepA, voffA);
            G_WAIT_V(8); G_WAIT_L(0); G_BAR; G_MMA(0, 0, At, B0); G_MMA(0, 1, At, B1); G_BAR; G_SCHED;
            G_LDA(At, 1, 1); G_STAGE(G_SB(1, 0), b3, voffB); G_STAGE(G_SB(1, 1), b3 + hstepB, voffB); G_STAGE(G_SA(1, 0), a3, voffA);
            G_WAIT_V(8); G_WAIT_L(0); G_BAR; G_MMA(1, 0, At, B0); G_MMA(1, 1, At, B1); G_BAR; G_SCHED;
        }
        if (wr == 0) G_BAR;
        if constexpr (!Epi::AFTER_DRAIN) E(acc, cur, wr, wc, fr, fq);
        if (!has_next) break;
#pragma unroll
        for (int a = 0; a < 2; ++a)
#pragma unroll
            for (int b = 0; b < 2; ++b)
#pragma unroll
                for (int m = 0; m < 4; ++m)
#pragma unroll
                    for (int n = 0; n < 2; ++n) acc[a][b][m][n] = (f32x4){0.f, 0.f, 0.f, 0.f};
        cur = nxt; cA = nA; cB = nB; ++ui;
        if (wr == 1) G_BAR;
    }
    G_WAIT_V(0);
    G_BAR;
    if constexpr (Epi::AFTER_DRAIN) E.fused(acc, cur, wr, wc, fr, fq, lds);
#undef G_SA
#undef G_SB
#undef G_STAGE
#undef G_LDA
#undef G_LDB
#undef G_MMA
#undef G_WAIT_V
#undef G_WAIT_L
#undef G_BAR
#undef G_SCHED
}

struct EpiGluH {
    static constexpr bool AFTER_DRAIN = false;
    bf16_t* H;
    __device__ __forceinline__ void operator()(Acc& acc, const Unit& u, int wr, int wc, int fr, int fq) const {
#pragma unroll
        for (int ai = 0; ai < 2; ++ai)
#pragma unroll
            for (int m = 0; m < 4; ++m) {
                const int r = u.r0 + 128 * ai + 64 * wr + 16 * m + fr;
                if (r < M) {
                    float h[8];
#pragma unroll
                    for (int n = 0; n < 2; ++n)
#pragma unroll
                        for (int j = 0; j < 4; ++j) h[4 * n + j] = silu_f(acc[ai][0][m][n][j]) * acc[ai][1][m][n][j];
                    u32x4 w; w.x = cvt_pk_bf16(h[0], h[1]); w.y = cvt_pk_bf16(h[2], h[3]); w.z = cvt_pk_bf16(h[4], h[5]); w.w = cvt_pk_bf16(h[6], h[7]);
                    *(u32x4*)(H + (size_t)r * FF + 128 * u.tn + 32 * wc + 8 * fq) = w;
                }
            }
    }
};
struct EpiResid {
    static constexpr bool AFTER_DRAIN = false;
    bf16_t* Z; const float* res0; const float* res1; float scale;
    __device__ __forceinline__ void operator()(Acc& acc, const Unit& u, int wr, int wc, int fr, int fq) const {
#pragma unroll
        for (int ai = 0; ai < 2; ++ai)
#pragma unroll
            for (int m = 0; m < 4; ++m) {
                const int r = u.r0 + 128 * ai + 64 * wr + 16 * m + fr;
                if (r < M) {
                    const float* rp = (r < MP) ? res0 + (size_t)r * D : res1 + (size_t)(r - MP) * D;
                    bf16_t* zp = Z + (size_t)r * D;
#pragma unroll
                    for (int bj = 0; bj < 2; ++bj) {
                        const int c = u.c0 + 128 * bj + 32 * wc + 8 * fq;
                        const f32x4 v0 = *(const f32x4*)(rp + c) * ALPHA + acc[ai][bj][m][0] * scale, v1 = *(const f32x4*)(rp + c + 4) * ALPHA + acc[ai][bj][m][1] * scale;
                        u32x4 w; w.x = cvt_pk_bf16(v0[0], v0[1]); w.y = cvt_pk_bf16(v0[2], v0[3]); w.z = cvt_pk_bf16(v1[0], v1[1]); w.w = cvt_pk_bf16(v1[2], v1[3]);
                        *(u32x4*)(zp + c) = w;
                    }
                }
            }
    }
};
struct EpiResidB {
    static constexpr bool AFTER_DRAIN = false;
    bf16_t* Z; const bf16_t* res; float scale;
    __device__ __forceinline__ void operator()(Acc& acc, const Unit& u, int wr, int wc, int fr, int fq) const {
#pragma unroll
        for (int ai = 0; ai < 2; ++ai)
#pragma unroll
            for (int m = 0; m < 4; ++m) {
                const int r = u.r0 + 128 * ai + 64 * wr + 16 * m + fr;
                const bf16_t* rp = res + (size_t)r * D; bf16_t* zp = Z + (size_t)r * D;
#pragma unroll
                for (int bj = 0; bj < 2; ++bj) {
                    const int c = u.c0 + 128 * bj + 32 * wc + 8 * fq;
                    const u32x4 rb = *(const u32x4*)(rp + c);
                    f32x4 r0, r1;
                    r0[0] = __builtin_bit_cast(float, rb[0] << 16); r0[1] = __builtin_bit_cast(float, rb[0] & 0xffff0000u); r0[2] = __builtin_bit_cast(float, rb[1] << 16); r0[3] = __builtin_bit_cast(float, rb[1] & 0xffff0000u);
                    r1[0] = __builtin_bit_cast(float, rb[2] << 16); r1[1] = __builtin_bit_cast(float, rb[2] & 0xffff0000u); r1[2] = __builtin_bit_cast(float, rb[3] << 16); r1[3] = __builtin_bit_cast(float, rb[3] & 0xffff0000u);
                    const f32x4 v0 = r0 * ALPHA + acc[ai][bj][m][0] * scale, v1 = r1 * ALPHA + acc[ai][bj][m][1] * scale;
                    u32x4 w; w.x = cvt_pk_bf16(v0[0], v0[1]); w.y = cvt_pk_bf16(v0[2], v0[3]); w.z = cvt_pk_bf16(v1[0], v1[1]); w.w = cvt_pk_bf16(v1[2], v1[3]);
                    *(u32x4*)(zp + c) = w;
                }
            }
    }
};
struct EpiPart {
    static constexpr bool AFTER_DRAIN = false;
    float* PART;
    __device__ __forceinline__ void operator()(Acc& acc, const Unit& u, int wr, int wc, int fr, int fq) const {
#pragma unroll
        for (int m = 0; m < 4; ++m) {
            const int rl = 64 * wr + 16 * m + fr;
            float* pp = PART + ((size_t)u.tn * 128 + rl) * D;
#pragma unroll
            for (int bj = 0; bj < 2; ++bj)
#pragma unroll
                for (int n = 0; n < 2; ++n) *(f32x4*)(pp + u.c0 + 128 * bj + 32 * wc + 8 * fq + 4 * n) = acc[0][bj][m][n];
        }
    }
};
struct EpiWin {
    static constexpr bool AFTER_DRAIN = false;
    float* PS; float* U;
    __device__ __forceinline__ void operator()(Acc& acc, const Unit& u, int wr, int wc, int fr, int fq) const {
#pragma unroll
        for (int ai = 0; ai < 2; ++ai)
#pragma unroll
            for (int m = 0; m < 4; ++m) {
                const int r = u.r0 + 128 * ai + 64 * wr + 16 * m + fr;
                if (r < M) {
                    if (u.tn < 14) {
#pragma unroll
                        for (int bj = 0; bj < 2; ++bj)
#pragma unroll
                            for (int n = 0; n < 2; ++n) {
                                const int c = u.c0 + 128 * bj + 32 * wc + 8 * fq + 4 * n;
                                if (c < SC) *(f32x4*)(PS + (size_t)r * SC + c) = acc[ai][bj][m][n];
                            }
                    } else {
#pragma unroll
                        for (int n = 0; n < 2; ++n) {
                            const int c = 128 * (u.tn - 14) + 32 * wc + 8 * fq + 4 * n;
                            f32x4 o;
#pragma unroll
                            for (int j = 0; j < 4; ++j) o[j] = acc[ai][0][m][n][j] * sigmoid_f(acc[ai][1][m][n][j]);
                            *(f32x4*)(U + (size_t)r * DC + c) = o;
                        }
                    }
                }
            }
    }
};
struct EpiLora {
    static constexpr bool AFTER_DRAIN = false;
    float* DAG; const float* w0; const float* a0;
    __device__ __forceinline__ void operator()(Acc& acc, const Unit& u, int wr, int wc, int fr, int fq) const {
        const int sec = u.tn >> 2;
#pragma unroll
        for (int ai = 0; ai < 2; ++ai)
#pragma unroll
            for (int m = 0; m < 4; ++m) {
                const int r = u.r0 + 128 * ai + 64 * wr + 16 * m + fr;
                if (r < M) {
#pragma unroll
                    for (int bj = 0; bj < 2; ++bj)
#pragma unroll
                        for (int n = 0; n < 2; ++n) {
                            const int c = u.c0 + 128 * bj + 32 * wc + 8 * fq + 4 * n, cc = c & 1023;
                            f32x4 o = acc[ai][bj][m][n];
                            if (sec == 0) {
                                const f32x4 wv = *(const f32x4*)(w0 + cc);
#pragma unroll
                                for (int j = 0; j < 4; ++j) o[j] = __expf(-0.6065306597126334f * sigmoid_f(wv[j] + o[j]));
                            } else if (sec == 1) {
                                const f32x4 av = *(const f32x4*)(a0 + cc);
#pragma unroll
                                for (int j = 0; j < 4; ++j) o[j] = sigmoid_f(av[j] + o[j]);
                            }
                            *(f32x4*)(DAG + (size_t)r * 3072 + c) = o;
                        }
                }
            }
    }
};
struct EpiBf16 {
    static constexpr bool AFTER_DRAIN = false;
    bf16_t* O; int ldc; float scale; int rlim;
    __device__ __forceinline__ void operator()(Acc& acc, const Unit& u, int wr, int wc, int fr, int fq) const {
#pragma unroll
        for (int ai = 0; ai < 2; ++ai)
#pragma unroll
            for (int m = 0; m < 4; ++m) {
                const int r = u.r0 + 128 * ai + 64 * wr + 16 * m + fr;
                if (r < rlim) {
#pragma unroll
                    for (int bj = 0; bj < 2; ++bj) {
                        const f32x4 v0 = acc[ai][bj][m][0] * scale, v1 = acc[ai][bj][m][1] * scale;
                        u32x4 w; w.x = cvt_pk_bf16(v0[0], v0[1]); w.y = cvt_pk_bf16(v0[2], v0[3]); w.z = cvt_pk_bf16(v1[0], v1[1]); w.w = cvt_pk_bf16(v1[2], v1[3]);
                        *(u32x4*)(O + (size_t)r * ldc + u.c0 + 128 * bj + 32 * wc + 8 * fq) = w;
                    }
                }
            }
    }
};
struct EpiMemKV {
    static constexpr bool AFTER_DRAIN = false;
    float* outK; float* outV; bf16_t* KB; bf16_t* VT;
    __device__ __forceinline__ void operator()(Acc& acc, const Unit& u, int wr, int wc, int fr, int fq) const {
#pragma unroll
        for (int ai = 0; ai < 2; ++ai)
#pragma unroll
            for (int m = 0; m < 4; ++m) {
                const int r = u.r0 + 128 * ai + 64 * wr + 16 * m + fr;
#pragma unroll
                for (int bj = 0; bj < 2; ++bj) {
                    const int c = u.c0 + 128 * bj + 32 * wc + 8 * fq;
                    const f32x4 v0 = acc[ai][bj][m][0], v1 = acc[ai][bj][m][1];
                    if (u.tn < 8) {
                        *(f32x4*)(outK + (size_t)r * D + c) = v0; *(f32x4*)(outK + (size_t)r * D + c + 4) = v1;
                        u32x4 w; w.x = cvt_pk_bf16(v0[0], v0[1]); w.y = cvt_pk_bf16(v0[2], v0[3]); w.z = cvt_pk_bf16(v1[0], v1[1]); w.w = cvt_pk_bf16(v1[2], v1[3]);
                        *(u32x4*)(KB + (size_t)r * D + c) = w;
                    } else {
                        const int cv = c - D;
                        *(f32x4*)(outV + (size_t)r * D + cv) = v0; *(f32x4*)(outV + (size_t)r * D + cv + 4) = v1;
                        bf16_t* vt = VT + ((size_t)(r >> 8) * D + cv) * NMEM + (r & 255);
#pragma unroll
                        for (int j = 0; j < 4; ++j) { vt[(size_t)j * NMEM] = f2bf(v0[j]); vt[(size_t)(4 + j) * NMEM] = f2bf(v1[j]); }
                    }
                }
            }
    }
};
struct EpiSoftmax {
    static constexpr bool AFTER_DRAIN = true;
    bf16_t* P;
    __device__ __forceinline__ void operator()(Acc&, const Unit&, int, int, int, int) const {}
    __device__ __forceinline__ void fused(Acc& acc, const Unit& u, int wr, int wc, int fr, int fq, LAS unsigned char* lds) const {
        LAS float* red = (LAS float*)lds;
        LAS float* red2 = red + 1024;
#pragma unroll
        for (int ai = 0; ai < 2; ++ai)
#pragma unroll
            for (int m = 0; m < 4; ++m) {
                float v = -3.0e38f;
#pragma unroll
                for (int bj = 0; bj < 2; ++bj)
#pragma unroll
                    for (int n = 0; n < 2; ++n)
#pragma unroll
                        for (int j = 0; j < 4; ++j) v = fmaxf(v, acc[ai][bj][m][n][j]);
                v = fmaxf(v, __shfl_xor(v, 16)); v = fmaxf(v, __shfl_xor(v, 32));
                if (fq == 0) red[wc * 256 + 128 * ai + 64 * wr + 16 * m + fr] = v;
            }
        __syncthreads();
#pragma unroll
        for (int ai = 0; ai < 2; ++ai)
#pragma unroll
            for (int m = 0; m < 4; ++m) {
                const int rl = 128 * ai + 64 * wr + 16 * m + fr;
                const float mx = fmaxf(fmaxf(red[rl], red[256 + rl]), fmaxf(red[512 + rl], red[768 + rl]));
                float s = 0.f;
#pragma unroll
                for (int bj = 0; bj < 2; ++bj)
#pragma unroll
                    for (int n = 0; n < 2; ++n)
#pragma unroll
                        for (int j = 0; j < 4; ++j) { const float e = __expf(acc[ai][bj][m][n][j] - mx); acc[ai][bj][m][n][j] = e; s += e; }
                s += __shfl_xor(s, 16); s += __shfl_xor(s, 32);
                if (fq == 0) red2[wc * 256 + rl] = s;
            }
        __syncthreads();
#pragma unroll
        for (int ai = 0; ai < 2; ++ai)
#pragma unroll
            for (int m = 0; m < 4; ++m) {
                const int rl = 128 * ai + 64 * wr + 16 * m + fr;
                const float inv = 1.f / ((red2[rl] + red2[256 + rl]) + (red2[512 + rl] + red2[768 + rl]));
#pragma unroll
                for (int bj = 0; bj < 2; ++bj) {
                    const f32x4 v0 = acc[ai][bj][m][0] * inv, v1 = acc[ai][bj][m][1] * inv;
                    u32x4 w; w.x = cvt_pk_bf16(v0[0], v0[1]); w.y = cvt_pk_bf16(v0[2], v0[3]); w.z = cvt_pk_bf16(v1[0], v1[1]); w.w = cvt_pk_bf16(v1[2], v1[3]);
                    *(u32x4*)(P + (size_t)(u.r0 + rl) * 1024 + u.c0 + 128 * bj + 32 * wc + 8 * fq) = w;
                }
            }
        __syncthreads();
    }
};

__device__ __forceinline__ void transpose_item(const float* W, int K, int N, bf16_t* WT, int k0, int n0, int drow0, LAS float* scr, int lane) {
    float tv[32];
#pragma unroll
    for (int i = 0; i < 32; ++i) tv[i] = __builtin_nontemporal_load(W + (size_t)(k0 + 2 * i + (lane >> 5)) * N + n0 + (lane & 31));
#pragma unroll
    for (int i = 0; i < 32; ++i) scr[(2 * i + (lane >> 5)) * 33 + (lane & 31)] = tv[i];
    asm volatile("s_waitcnt lgkmcnt(0)" ::: "memory");
    const int c = lane & 7;
#pragma unroll
    for (int j = 0; j < 4; ++j) { const int n = (lane >> 3) + 8 * j; const LAS float* s = scr + (8 * c) * 33 + n;
        u32x4 o; o.x = cvt_pk_bf16(s[0 * 33], s[1 * 33]); o.y = cvt_pk_bf16(s[2 * 33], s[3 * 33]); o.z = cvt_pk_bf16(s[4 * 33], s[5 * 33]); o.w = cvt_pk_bf16(s[6 * 33], s[7 * 33]);
        *(u32x4*)(WT + (size_t)(drow0 + n) * K + k0 + 8 * c) = o; }
    asm volatile("s_waitcnt lgkmcnt(0)" ::: "memory");
}
__device__ __forceinline__ int glu_row(int n0, int which) { return (n0 >> 7) * 256 + which * 128 + (n0 & 127); }
__device__ __forceinline__ int win_row(int n0) {
    if (n0 < SC) return n0;
    if (n0 < SC + DC) return 3584 + glu_row(n0 - SC, 0);
    return 3584 + glu_row(n0 - SC - DC, 1);
}
__device__ __forceinline__ void phase_prep(const Params& p, LAS unsigned char* lds, int G, int bid) {
    const int tid = threadIdx.x, lane = tid & 63, wid = tid >> 6;
    const int gw = bid * 8 + wid, NGW = G * 8;
    LAS float* scr = (LAS float*)(lds + wid * 8704);
    unsigned char* ws = p.ws;
    constexpr int I_FF = (D / 64) * (FF / 32);
    constexpr int I_IN = (D / 64) * (5408 / 32);
    constexpr int I_SQ = (D / 64) * (D / 32);
    constexpr int NITEMS = 6 * I_FF + I_IN + 5 * I_SQ;
    for (int it = gw; it < NITEMS; it += NGW) {
        int r = NITEMS - 1 - it;
        if (r < 6 * I_FF) {
            const int which = r / I_FF; r -= which * I_FF;
            const int layer = which / 3, kind = which % 3;
            if (kind < 2) {
                const float* W = p.in[layer ? (kind ? I_F2W3 : I_F2W1) : (kind ? I_F1W3 : I_F1W1)];
                bf16_t* WT = (bf16_t*)(ws + (layer ? WS_W13B : WS_W13A));
                const int nblk = FF / 32, kb = r / nblk, nb = r % nblk;
                transpose_item(W, D, FF, WT, kb * 64, nb * 32, glu_row(nb * 32, kind), scr, lane);
            } else {
                const float* W = p.in[layer ? I_F2W2 : I_F1W2];
                bf16_t* WT = (bf16_t*)(ws + (layer ? WS_W2B : WS_W2A));
                const int nblk = D / 32, kb = r / nblk, nb = r % nblk;
                transpose_item(W, FF, D, WT, kb * 64, nb * 32, nb * 32, scr, lane);
            }
            continue;
        }
        r -= 6 * I_FF;
        if (r < I_IN) {
            const int nblk = 5408 / 32, kb = r / nblk, nb = r % nblk;
            transpose_item(p.in[I_WIN], D, 5408, (bf16_t*)(ws + WS_WIN), kb * 64, nb * 32, win_row(nb * 32), scr, lane);
            continue;
        }
        r -= I_IN;
        {
            const int which = r / I_SQ; r -= which * I_SQ;
            const int idx = which == 0 ? I_WOUT : which == 1 ? I_WMQ : which == 2 ? I_WMK : which == 3 ? I_WMV : I_WMO;
            const size_t off = which == 0 ? WS_WOUT : which == 1 ? WS_WMQ : which == 2 ? WS_WMK : which == 3 ? WS_WMV : WS_WMO;
            const int nblk = D / 32, kb = r / nblk, nb = r % nblk;
            transpose_item(p.in[idx], D, D, (bf16_t*)(ws + off), kb * 64, nb * 32, nb * 32, scr, lane);
        }
    }
    const int gt = bid * 512 + tid, NGT = G * 512;
    { u32x4* z = (u32x4*)(ws + WS_WIN + (size_t)SC * D * 2); const int n16 = (3584 - SC) * D * 2 / 16;
      for (int i = gt; i < n16; i += NGT) z[i] = (u32x4){0u, 0u, 0u, 0u}; }
    { bf16_t* WL = (bf16_t*)(ws + WS_WLORA);
      for (int i = gt; i < 3072 * LK; i += NGT) {
          const int n = i / LK, k = i % LK; float v = 0.f;
          if (n < 1024) { if (k < 64) v = p.in[I_W2D][(size_t)k * DR + n]; }
          else if (n < 2048) { if (k >= 64 && k < 128) v = p.in[I_A2][(size_t)(k - 64) * DR + (n - 1024)]; }
          else { if (k >= 128 && k < 288) v = p.in[I_G2][(size_t)(k - 128) * DR + (n - 2048)]; }
          WL[i] = f2bf(v);
      } }
    { u32x2* xb = (u32x2*)(ws + WS_XB); const f32x4* xp = (const f32x4*)p.in[I_XP]; const f32x4* xs = (const f32x4*)p.in[I_XS];
      constexpr int NP4 = MP * D / 4, NA4 = M * D / 4;
      for (int i = gt; i < NA4; i += NGT) { const f32x4 v = (i < NP4) ? xp[i] : xs[i - NP4]; xb[i] = (u32x2){cvt_pk_bf16(v[0], v[1]), cvt_pk_bf16(v[2], v[3])}; }
      u32x2* mb = (u32x2*)(ws + WS_MEMB); const f32x4* mp = (const f32x4*)p.in[I_MEM];
      for (int i = gt; i < 1024 * D / 4; i += NGT) { const f32x4 v = mp[i]; mb[i] = (u32x2){cvt_pk_bf16(v[0], v[1]), cvt_pk_bf16(v[2], v[3])}; } }
}

__device__ __forceinline__ void ln_finish(f32x4 (&v)[8], int row, int lane, const float* g, const float* b, float* outF, bf16_t* outB) {
    float s = 0.f;
#pragma unroll
    for (int j = 0; j < 8; ++j) s += (v[j][0] + v[j][1]) + (v[j][2] + v[j][3]);
    const float mean = wave_sum(s) * (1.f / D); float s2 = 0.f;
#pragma unroll
    for (int j = 0; j < 8; ++j) { v[j] = v[j] - mean; s2 += (v[j][0] * v[j][0] + v[j][1] * v[j][1]) + (v[j][2] * v[j][2] + v[j][3] * v[j][3]); }
    const float rstd = 1.f / sqrtf(wave_sum(s2) * (1.f / D) + LN_EPS);
#pragma unroll
    for (int j = 0; j < 8; ++j) {
        const f32x4 gv = ((const f32x4*)g)[64 * j + lane], bv = ((const f32x4*)b)[64 * j + lane];
        const f32x4 y = v[j] * rstd * gv + bv;
        if (outF) ((f32x4*)(outF + (size_t)row * D))[64 * j + lane] = y;
        if (outB) ((u32x2*)(outB + (size_t)row * D))[64 * j + lane] = (u32x2){cvt_pk_bf16(y[0], y[1]), cvt_pk_bf16(y[2], y[3])};
    }
}
__device__ __forceinline__ void phase_ln(LAS unsigned char* lds, const bf16_t* Z, const float* g, const float* b, float* outF, bf16_t* outB, int G, int bid, const float* PART, int nsl, const float* res1, const bf16_t* res1b, float scale) {
    const int tid = threadIdx.x, lane = tid & 63, wid = tid >> 6;
    const int gw = bid * 8 + wid, NGW = G * 8;
    f32x4 pl[22]; f32x4 rvs = (f32x4){0.f, 0.f, 0.f, 0.f};
    if (bid < MS) {
#pragma unroll
        for (int sl = 0; sl < 22; ++sl) if (sl < nsl) pl[sl] = ((const f32x4*)(PART + ((size_t)sl * 128 + bid) * D))[64 * wid + lane];
        if (res1) rvs = ((const f32x4*)(res1 + (size_t)bid * D))[64 * wid + lane];
        else { const u32x2 rb = ((const u32x2*)(res1b + (size_t)bid * D))[64 * wid + lane];
               rvs[0] = __builtin_bit_cast(float, rb[0] << 16); rvs[1] = __builtin_bit_cast(float, rb[0] & 0xffff0000u); rvs[2] = __builtin_bit_cast(float, rb[1] << 16); rvs[3] = __builtin_bit_cast(float, rb[1] & 0xffff0000u); }
    }
    {
        f32x4 cur[8], nxt[8];
        int row = gw;
        if (row < MP) {
#pragma unroll
            for (int j = 0; j < 8; ++j) { const u32x2 zb = ((const u32x2*)(Z + (size_t)row * D))[64 * j + lane]; cur[j][0] = __builtin_bit_cast(float, zb[0] << 16); cur[j][1] = __builtin_bit_cast(float, zb[0] & 0xffff0000u); cur[j][2] = __builtin_bit_cast(float, zb[1] << 16); cur[j][3] = __builtin_bit_cast(float, zb[1] & 0xffff0000u); }
        }
#pragma unroll 1
        while (row < MP) {
            const int nrow = row + NGW;
            if (nrow < MP) {
#pragma unroll
                for (int j = 0; j < 8; ++j) { const u32x2 zb = ((const u32x2*)(Z + (size_t)nrow * D))[64 * j + lane]; nxt[j][0] = __builtin_bit_cast(float, zb[0] << 16); nxt[j][1] = __builtin_bit_cast(float, zb[0] & 0xffff0000u); nxt[j][2] = __builtin_bit_cast(float, zb[1] << 16); nxt[j][3] = __builtin_bit_cast(float, zb[1] & 0xffff0000u); }
            }
            ln_finish(cur, row, lane, g, b, outF, outB);
#pragma unroll
            for (int j = 0; j < 8; ++j) cur[j] = nxt[j];
            row = nrow;
        }
    }
    if (bid < MS) {
        const int sr = bid;
        LAS float* red = (LAS float*)lds;
        f32x4 a = (f32x4){0.f, 0.f, 0.f, 0.f};
#pragma unroll
        for (int sl = 0; sl < 22; ++sl) if (sl < nsl) a += pl[sl];
        const f32x4 rv = rvs;
        f32x4 v = rv * ALPHA + a * scale;
        const float ps = wave_sum((v[0] + v[1]) + (v[2] + v[3]));
        if (lane == 0) red[wid] = ps;
        __syncthreads();
        const float mean = (((red[0] + red[1]) + (red[2] + red[3])) + ((red[4] + red[5]) + (red[6] + red[7]))) * (1.f / D);
        v = v - mean;
        const float ps2 = wave_sum((v[0] * v[0] + v[1] * v[1]) + (v[2] * v[2] + v[3] * v[3]));
        if (lane == 0) red[8 + wid] = ps2;
        __syncthreads();
        const float rstd = 1.f / sqrtf((((red[8] + red[9]) + (red[10] + red[11])) + ((red[12] + red[13]) + (red[14] + red[15]))) * (1.f / D) + LN_EPS);
        const f32x4 gv = ((const f32x4*)g)[64 * wid + lane], bv = ((const f32x4*)b)[64 * wid + lane];
        const f32x4 y = v * rstd * gv + bv;
        if (outF) ((f32x4*)(outF + (size_t)(MP + sr) * D))[64 * wid + lane] = y;
        if (outB) ((u32x2*)(outB + (size_t)(MP + sr) * D))[64 * wid + lane] = (u32x2){cvt_pk_bf16(y[0], y[1]), cvt_pk_bf16(y[2], y[3])};
        __syncthreads();
    }
}

__device__ __forceinline__ void load_rkv_raw(const Params& p, int row, int ch, float (&c)[3], float (&q)[3]) {
    const float* PS = (const float*)(p.ws + WS_RA);
    const float* cur = PS + (size_t)row * SC;
    const float* prev;
    if (row < MP) { const int t = row & (SEQ - 1); prev = PS + (size_t)(row - (t ? 1 : 0)) * SC; }
    else prev = p.in[I_SSH] + (size_t)(row - MP) * SC;
    c[0] = cur[ch]; c[1] = cur[1024 + ch]; c[2] = cur[2048 + ch];
    q[0] = prev[ch]; q[1] = prev[1024 + ch]; q[2] = prev[2048 + ch];
}
__device__ __forceinline__ void load_rkv_cur(const Params& p, int row, int ch, float (&c)[3]) {
    const float* cur = (const float*)(p.ws + WS_RA) + (size_t)row * SC;
    c[0] = cur[ch]; c[1] = cur[1024 + ch]; c[2] = cur[2048 + ch];
}
__device__ __forceinline__ void load_rkv_prev(const Params& p, int row, int ch, float (&q)[3]) {
    const int t = row & (SEQ - 1);
    const float* prev = (const float*)(p.ws + WS_RA) + (size_t)(row - (t ? 1 : 0)) * SC;
    q[0] = prev[ch]; q[1] = prev[1024 + ch]; q[2] = prev[2048 + ch];
}
__device__ __forceinline__ float shift_mix(float c, float q, float mu, bool zprev) { const float pq = zprev ? 0.f : q; return c + mu * (pq - c); }
__device__ __forceinline__ void phase_mixpre(const Params& p, int G, int bid) {
    const int tid = threadIdx.x, lane = tid & 63, wid = tid >> 6;
    const int gw = bid * 8 + wid, NGW = G * 8;
    unsigned char* ws = p.ws;
    const float* PS = (const float*)(ws + WS_RA); bf16_t* LA = (bf16_t*)(ws + WS_LA);
    const float* mu = p.in[I_MU];
    for (int row = gw; row < M; row += NGW) {
        const f32x4* cur = (const f32x4*)(PS + (size_t)row * SC);
        const f32x4* prev; bool zprev = false; float* shout = nullptr;
        if (row < MP) { const int t = row & (SEQ - 1); zprev = (t == 0); prev = (const f32x4*)(PS + (size_t)(row - (zprev ? 0 : 1)) * SC);
                        if (t == SEQ - 1) shout = p.out + O_SHP + (size_t)(row >> 11) * SC; }
        else { prev = (const f32x4*)(p.in[I_SSH] + (size_t)(row - MP) * SC); shout = p.out + O_SHS + (size_t)(row - MP) * SC; }
        if (shout) for (int i = lane; i < SC / 4; i += 64) ((f32x4*)shout)[i] = cur[i];
        for (int i = 768 + lane; i < SC / 4; i += 64) {
            const f32x4 c = cur[i]; f32x4 pv = prev[i]; if (zprev) pv = (f32x4){0.f, 0.f, 0.f, 0.f};
            const f32x4 m4 = ((const f32x4*)mu)[i];
            const f32x4 pm = c + m4 * (pv - c);
            const int col = 4 * i;
            f32x4 a;
            if (col < 3136) { for (int j = 0; j < 4; ++j) a[j] = tanhf(pm[j]); }
            else if (col < 3200) a = pm;
            else { for (int j = 0; j < 4; ++j) a[j] = 1.f / (1.f + expf(-pm[j])); }
            *(u32x2*)(LA + (size_t)row * LK + (col - 3072)) = (u32x2){cvt_pk_bf16(a[0], a[1]), cvt_pk_bf16(a[2], a[3])};
        }
        if (lane < 24) *(u32x2*)(LA + (size_t)row * LK + 288 + 4 * lane) = (u32x2){0u, 0u};
    }
    const int gt = bid * 512 + tid, NGT = G * 512;
    const f32x4* U4 = (const f32x4*)(ws + WS_U);
    { f32x4* o = (f32x4*)(p.out + O_CVP);
      for (int i = gt; i < NB * 30 * DC / 4; i += NGT) { const int c4 = i & 255, j = (i >> 8) % 30, b = (i >> 8) / 30; o[i] = U4[(size_t)(b * SEQ + SEQ - 30 + j) * 256 + c4]; } }
    { f32x4* o = (f32x4*)(p.out + O_CVS); const f32x4* sc = (const f32x4*)p.in[I_SCV];
      for (int i = gt; i < MS * 30 * DC / 4; i += NGT) { const int c4 = i & 255, j = (i >> 8) % 30, s = (i >> 8) / 30;
          o[i] = (j < 29) ? sc[(size_t)(s * 30 + j + 1) * 256 + c4] : U4[(size_t)(MP + s) * 256 + c4]; } }
}

constexpr int TC = 32;
__device__ __forceinline__ void rwkv_sample8(const Params& p, LAS unsigned char* lds, int j0) {
    LAS float* sR = (LAS float*)lds; LAS float* sK = sR + 8 * 64; LAS float* sV = sK + 8 * 64; LAS float* sW = sV + 8 * 64;
    LAS float* sKK = sW + 8 * 64; LAS float* sB = sKK + 8 * 64; LAS float* sY = sB + 8 * 64;
    const int tid = threadIdx.x, lane = tid & 63, wid = tid >> 6;
    const int v = wid * 8 + (lane >> 3), kq = lane & 7;
    const float* DAG = (const float*)(p.ws + WS_RB); bf16_t* OMIX = (bf16_t*)(p.ws + WS_OMIX);
    const int jw = j0 + wid, sw = jw >> 4, hw = jw & 15, roww = MP + sw, ch = hw * 64 + lane;
    const float rk_w = p.in[I_RK][ch], gng = p.in[I_GNG][ch], gnb = p.in[I_GNB][ch], beta = p.in[I_BR][ch];
    {
        const float mu_r = p.in[I_MU][ch], mu_k = p.in[I_MU][1024 + ch], mu_v = p.in[I_MU][2048 + ch], kk_w = p.in[I_KK][ch], ka_w = p.in[I_KA][ch];
        const float* dag = DAG + (size_t)roww * 3072;
        float cc[3], qq[3]; load_rkv_raw(p, roww, ch, cc, qq);
        const float r = shift_mix(cc[0], qq[0], mu_r, false), k = shift_mix(cc[1], qq[1], mu_k, false), vv = shift_mix(cc[2], qq[2], mu_v, false), w = dag[ch], a = dag[1024 + ch];
        const float kr = k * kk_w; const float n2 = wave_sum(kr * kr); const float kk = kr / fmaxf(sqrtf(n2), 1e-12f);
        const float kp = k * (1.f + (a - 1.f) * ka_w);
        const int o = wid * 64 + lane;
        sR[o] = r; sK[o] = kp; sV[o] = vv; sW[o] = w; sKK[o] = kk; sB[o] = kk * a;
    }
    f32x4 Sa[8], Sb[8];
#pragma unroll
    for (int q = 0; q < 8; ++q) { const float* st = p.in[I_SWKV] + (size_t)(j0 + q) * HD * HD + v * 64 + kq * 8; Sa[q] = *(const f32x4*)st; Sb[q] = *(const f32x4*)(st + 4); }
    __syncthreads();
#pragma unroll
    for (int q = 0; q < 8; ++q) {
        const int o = q * 64 + kq * 8;
        const f32x4 w0 = *(const LAS f32x4*)(sW + o), w1 = *(const LAS f32x4*)(sW + o + 4);
        const f32x4 q0 = *(const LAS f32x4*)(sKK + o), q1 = *(const LAS f32x4*)(sKK + o + 4);
        const f32x4 b0 = *(const LAS f32x4*)(sB + o), b1 = *(const LAS f32x4*)(sB + o + 4);
        const f32x4 k0 = *(const LAS f32x4*)(sK + o), k1 = *(const LAS f32x4*)(sK + o + 4);
        const f32x4 r0 = *(const LAS f32x4*)(sR + o), r1 = *(const LAS f32x4*)(sR + o + 4);
        const float vv = sV[q * 64 + v];
        f32x4 A = Sa[q], B = Sb[q];
        float sa = 0.f;
#pragma unroll
        for (int j = 0; j < 4; ++j) { sa += A[j] * q0[j]; sa += B[j] * q1[j]; }
        sa = -red8(sa);
        float y = 0.f;
#pragma unroll
        for (int j = 0; j < 4; ++j) {
            A[j] = A[j] * w0[j] + sa * b0[j] + vv * k0[j];
            B[j] = B[j] * w1[j] + sa * b1[j] + vv * k1[j];
            y += A[j] * r0[j]; y += B[j] * r1[j];
        }
        y = red8(y);
        if (kq == 0) sY[q * 64 + v] = y;
        float* so = p.out + O_WKS + (size_t)(j0 + q) * HD * HD + v * 64 + kq * 8;
        *(f32x4*)so = A; *(f32x4*)(so + 4) = B;
    }
    __syncthreads();
    {
        const int o = wid * 64 + lane;
        const float y = sY[o];
        const float mu = wave_sum(y) * (1.f / 64.f); const float d = y - mu; const float var = wave_sum(d * d) * (1.f / 64.f);
        const float yn = d * (1.f / sqrtf(var + GN_EPS)) * gng + gnb;
        const float bonus = wave_sum(sR[o] * sK[o] * rk_w) * sV[o];
        const float g = DAG[(size_t)roww * 3072 + 2048 + ch];
        OMIX[(size_t)roww * D + ch] = f2bf((yn + bonus) * g * beta);
    }
    __syncthreads();
}

__device__ __forceinline__ void conv_item(const Params& p, LAS unsigned char* lds, int it) {
    const int tid = threadIdx.x, lane = tid & 63, wid = tid >> 6;
    const int c = 2 * tid;
    const float* U = (const float*)(p.ws + WS_U); bf16_t* OMIX = (bf16_t*)(p.ws + WS_OMIX);
    const bool samp = it >= 1024;
    const int b = it >> 8, t0 = (it & 255) * 8, s = it - 1024;
    const int row0 = samp ? MP + s : b * SEQ + t0;
    const int ntok = samp ? 1 : 8;
    f32x2 w[CW];
#pragma unroll
    for (int j = 0; j < CW; ++j) w[j] = *(const f32x2*)(p.in[I_CVW] + (size_t)j * DC + c);
    const f32x2 bias = *(const f32x2*)(p.in[I_CVB] + c);
    f32x2 acc[8];
#pragma unroll
    for (int i = 0; i < 8; ++i) acc[i] = bias;
#pragma unroll
    for (int q = 0; q < 38; ++q) {
        f32x2 u = (f32x2){0.f, 0.f};
        if (samp) { if (q < 30) u = *(const f32x2*)(p.in[I_SCV] + (size_t)(s * 30 + q) * DC + c); else if (q == 30) u = *(const f32x2*)(U + (size_t)(MP + s) * DC + c); }
        else { const int t = t0 - 30 + q; if (t >= 0) u = *(const f32x2*)(U + (size_t)(b * SEQ + t) * DC + c); }
#pragma unroll
        for (int i = 0; i < 8; ++i) { const int j = q - i; if (j >= 0 && j < CW) acc[i] += w[j] * u; }
    }
    LAS float* sC = (LAS float*)lds;
#pragma unroll
    for (int i = 0; i < 8; ++i) *(LAS f32x2*)(sC + i * DC + c) = acc[i];
    __syncthreads();
    if (wid < ntok) {
        const LAS f32x4* cr = (const LAS f32x4*)(sC + wid * DC) + lane;
        f32x4 v[4]; float sm = 0.f;
#pragma unroll
        for (int j = 0; j < 4; ++j) { v[j] = cr[64 * j]; sm += (v[j][0] + v[j][1]) + (v[j][2] + v[j][3]); }
        const float mean = wave_sum(sm) * (1.f / DC); float s2 = 0.f;
#pragma unroll
        for (int j = 0; j < 4; ++j) { v[j] = v[j] - mean; s2 += (v[j][0] * v[j][0] + v[j][1] * v[j][1]) + (v[j][2] * v[j][2] + v[j][3] * v[j][3]); }
        const float rstd = 1.f / sqrtf(wave_sum(s2) * (1.f / DC) + LN_EPS);
        bf16_t* orow = OMIX + (size_t)(row0 + wid) * D + DR;
#pragma unroll
        for (int j = 0; j < 4; ++j) {
            const f32x4 gv = ((const f32x4*)p.in[I_CLG])[64 * j + lane], bv = ((const f32x4*)p.in[I_CLB])[64 * j + lane], be = ((const f32x4*)p.in[I_BC])[64 * j + lane];
            f32x4 y = v[j] * rstd * gv + bv;
#pragma unroll
            for (int e = 0; e < 4; ++e) y[e] = y[e] / (1.f + expf(-y[e])) * be[e];
            ((u32x2*)orow)[64 * j + lane] = (u32x2){cvt_pk_bf16(y[0], y[1]), cvt_pk_bf16(y[2], y[3])};
        }
    }
    __syncthreads();
}
constexpr int SBUF = 6 * TC * 64;
struct ProdRegs { float c[8][3], q0[3], w[8], a[8]; };
__device__ __forceinline__ void prod_load(const Params& p, ProdRegs& R, int row0, int h, int pw, int lane) {
    const float* DAG = (const float*)(p.ws + WS_RB);
    const int ch = h * 64 + lane;
#pragma unroll
    for (int i = 0; i < 8; ++i) {
        const int s = pw * 8 + i;
        const float* dag = DAG + (size_t)(row0 + s) * 3072;
        load_rkv_cur(p, row0 + s, ch, R.c[i]);
        R.w[i] = dag[ch]; R.a[i] = dag[1024 + ch];
    }
    load_rkv_prev(p, row0 + pw * 8, ch, R.q0);
}
__device__ __forceinline__ void prod_store(const ProdRegs& R, LAS float* buf, int row0, int pw, int lane, float kk_w, float ka_w, float mu_r, float mu_k, float mu_v) {
#pragma unroll
    for (int i = 0; i < 8; ++i) {
        const int s = pw * 8 + i;
        const bool zp = (i == 0) && (((row0 + s) & (SEQ - 1)) == 0);
        const float qr = i ? R.c[i ? i - 1 : 0][0] : R.q0[0], qk = i ? R.c[i ? i - 1 : 0][1] : R.q0[1], qv = i ? R.c[i ? i - 1 : 0][2] : R.q0[2];
        const float r = shift_mix(R.c[i][0], qr, mu_r, zp), k = shift_mix(R.c[i][1], qk, mu_k, zp), vv = shift_mix(R.c[i][2], qv, mu_v, zp);
        const float kr = k * kk_w; const float n2 = wave_sum(kr * kr); const float kk = kr * __builtin_amdgcn_rsqf(fmaxf(n2, 1e-24f));
        const float kp = k * (1.f + (R.a[i] - 1.f) * ka_w);
        const int o = s * 64 + lane;
        buf[o] = r; buf[TC * 64 + o] = kp; buf[2 * TC * 64 + o] = vv; buf[3 * TC * 64 + o] = R.w[i]; buf[4 * TC * 64 + o] = kk; buf[5 * TC * 64 + o] = kk * R.a[i];
    }
}
struct StepRegs { f32x4 r4, k4, w4, q4, b4; float vv; };
__device__ __forceinline__ void step_load(StepRegs& T, const LAS float* pb, const LAS float* pv, int s) {
    T.r4 = *(const LAS f32x4*)(pb + s * 64); T.k4 = *(const LAS f32x4*)(pb + TC * 64 + s * 64); T.w4 = *(const LAS f32x4*)(pb + 3 * TC * 64 + s * 64);
    T.q4 = *(const LAS f32x4*)(pb + 4 * TC * 64 + s * 64); T.b4 = *(const LAS f32x4*)(pb + 5 * TC * 64 + s * 64); T.vv = pv[s * 64];
}
__device__ __forceinline__ f32x2 lo2(const f32x4& a) { return __builtin_shufflevector(a, a, 0, 1); }
__device__ __forceinline__ f32x2 hi2(const f32x4& a) { return __builtin_shufflevector(a, a, 2, 3); }
__device__ __forceinline__ void red16x2(float& a, float& b) {
    a += dppf<0xB1>(a); b += dppf<0xB1>(b); a += dppf<0x4E>(a); b += dppf<0x4E>(b);
    a += dppf<0x141>(a); b += dppf<0x141>(b); a += dppf<0x140>(a); b += dppf<0x140>(b);
}
template <bool STORE>
__device__ __forceinline__ void step_compute(const StepRegs& T, const f32x4& rprev, f32x2& S01, f32x2& S23, float* yprev) {
    const f32x2 vv2 = (f32x2){T.vv, T.vv};
    const f32x2 t01 = S01 * lo2(T.w4) + vv2 * lo2(T.k4), t23 = S23 * hi2(T.w4) + vv2 * hi2(T.k4);
    const f32x2 dv = S23 * hi2(T.q4) + S01 * lo2(T.q4);
    const f32x2 ev = S23 * hi2(rprev) + S01 * lo2(rprev);
    float d = dv[0] + dv[1], e = ev[0] + ev[1];
    red16x2(d, e);
    if (STORE) *yprev = e;
    const f32x2 d2 = (f32x2){d, d};
    S01 = t01 - d2 * lo2(T.b4); S23 = t23 - d2 * hi2(T.b4);
}
__device__ __forceinline__ void scan_consume(const LAS float* buf, f32x2& S01, f32x2& S23, int v, int kq, float* Yp) {
    const LAS float* pb = buf + kq * 4; const LAS float* pv = buf + 2 * TC * 64 + v;
    StepRegs A, B;
    step_load(A, pb, pv, 0);
    step_load(B, pb, pv, 1);
    step_compute<false>(A, A.r4, S01, S23, Yp);
#pragma unroll
    for (int s = 1; s < TC; s += 2) {
        const f32x4 rA = A.r4;
        if (s + 1 < TC) step_load(A, pb, pv, s + 1);
        step_compute<true>(B, rA, S01, S23, Yp + (size_t)(s - 1) * 1024);
        if (s + 1 < TC) {
            const f32x4 rB = B.r4;
            if (s + 2 < TC) step_load(B, pb, pv, s + 2);
            step_compute<true>(A, rB, S01, S23, Yp + (size_t)s * 1024);
        }
    }
    { const f32x2 ev = S23 * hi2(B.r4) + S01 * lo2(B.r4); Yp[(size_t)(TC - 1) * 1024] = red16(ev[0] + ev[1]); }
}
__device__ __forceinline__ void phase_scan(const Params& p, LAS unsigned char* lds, int G, int bid) {
    const int tid = threadIdx.x, lane = tid & 63, wid = __builtin_amdgcn_readfirstlane(tid >> 6);
    LAS float* buf0 = (LAS float*)lds; LAS float* buf1 = buf0 + SBUF;
    float* Y = (float*)(p.ws + WS_Y);
    constexpr int NCH = SEQ / TC;
    for (int item = bid; item < NB * NH * 4; item += G) {
        const int bh = item >> 2, qd = item & 3, b = bh >> 4, h = bh & 15, row0 = b * SEQ;
        const int ch = h * 64 + lane;
        const float kk_w = p.in[I_KK][ch], ka_w = p.in[I_KA][ch], mu_r = p.in[I_MU][ch], mu_k = p.in[I_MU][1024 + ch], mu_v = p.in[I_MU][2048 + ch];
        f32x2 S01 = (f32x2){0.f, 0.f}, S23 = (f32x2){0.f, 0.f};
        const int v = qd * 16 + (wid & 3) * 4 + (lane >> 4), kq = lane & 15;
        ProdRegs R;
        if (wid >= 4) { prod_load(p, R, row0, h, wid - 4, lane); prod_store(R, buf0, row0, wid - 4, lane, kk_w, ka_w, mu_r, mu_k, mu_v); prod_load(p, R, row0 + TC, h, wid - 4, lane); }
        asm volatile("s_waitcnt lgkmcnt(0)" ::: "memory"); __builtin_amdgcn_s_barrier(); asm volatile("" ::: "memory");
#pragma unroll 1
        for (int c = 0; c < NCH; ++c) {
            LAS float* cb = (c & 1) ? buf1 : buf0; LAS float* nb = (c & 1) ? buf0 : buf1;
            if (wid < 4) scan_consume(cb, S01, S23, v, kq, Y + (size_t)(row0 + c * TC) * 1024 + h * 64 + v);
            else {
                if (c + 1 < NCH) prod_store(R, nb, row0 + (c + 1) * TC, wid - 4, lane, kk_w, ka_w, mu_r, mu_k, mu_v);
                if (c + 2 < NCH) prod_load(p, R, row0 + (c + 2) * TC, h, wid - 4, lane);
            }
            asm volatile("s_waitcnt lgkmcnt(0)" ::: "memory"); __builtin_amdgcn_s_barrier(); asm volatile("" ::: "memory");
        }
        if (wid < 4) *(f32x4*)(p.out + O_WKP + (size_t)bh * HD * HD + v * 64 + kq * 4) = (f32x4){S01[0], S01[1], S23[0], S23[1]};
    }
}
__device__ __forceinline__ void phase_mix2(const Params& p, LAS unsigned char* lds, int G, int bid) {
    const int tid = threadIdx.x, lane = tid & 63, wid = tid >> 6;
    {
        const float* DAG = (const float*)(p.ws + WS_RB); const float* Y = (const float*)(p.ws + WS_Y); bf16_t* OMIX = (bf16_t*)(p.ws + WS_OMIX);
        const int gw = bid * 8 + wid, NGW = G * 8;
        const int h = gw & 15, ch = h * 64 + lane;
        const float ka_w = p.in[I_KA][ch], rk_w = p.in[I_RK][ch], gng = p.in[I_GNG][ch], gnb = p.in[I_GNB][ch], beta = p.in[I_BR][ch];
        const float mu_r = p.in[I_MU][ch], mu_k = p.in[I_MU][1024 + ch], mu_v = p.in[I_MU][2048 + ch];
        const int rstep = NGW >> 4;
        for (int grp = gw >> 4; grp < MP / 4; grp += rstep) {
            const int rb = grp * 4;
            float y[4], cc[4][3], q0[3], a[4], g[4];
#pragma unroll
            for (int u = 0; u < 4; ++u) {
                const int row = rb + u; const float* dag = DAG + (size_t)row * 3072;
                load_rkv_cur(p, row, ch, cc[u]); y[u] = Y[(size_t)row * 1024 + ch]; a[u] = dag[1024 + ch]; g[u] = dag[2048 + ch];
            }
            load_rkv_prev(p, rb, ch, q0);
#pragma unroll
            for (int u = 0; u < 4; ++u) {
                const int row = rb + u;
                const bool zp = (u == 0) && ((row & (SEQ - 1)) == 0);
                const float qr = u ? cc[u ? u - 1 : 0][0] : q0[0], qk = u ? cc[u ? u - 1 : 0][1] : q0[1], qv = u ? cc[u ? u - 1 : 0][2] : q0[2];
                const float r = shift_mix(cc[u][0], qr, mu_r, zp), k = shift_mix(cc[u][1], qk, mu_k, zp), vv = shift_mix(cc[u][2], qv, mu_v, zp);
                const float kp = k * (1.f + (a[u] - 1.f) * ka_w);
                const float mu = wave_sum(y[u]) * (1.f / 64.f); const float d = y[u] - mu; const float var = wave_sum(d * d) * (1.f / 64.f);
                const float yn = d * (1.f / sqrtf(var + GN_EPS)) * gng + gnb;
                const float bonus = wave_sum(r * kp * rk_w) * vv;
                OMIX[(size_t)row * D + ch] = f2bf((yn + bonus) * g[u] * beta);
            }
        }
    }
    constexpr int NCONV = 1024 + MS, NSAMP8 = MS * NH / 8;
    for (int it = bid; it < NCONV + NSAMP8; it += G) {
        if (it < NCONV) conv_item(p, lds, it);
        else rwkv_sample8(p, lds, (it - NCONV) * 8);
    }
}

__device__ __forceinline__ void samp_attn_item(const Params& p, LAS unsigned char* lds, int it) {
    const int tid = threadIdx.x, lane = tid & 63, wid = tid >> 6;
    const int s = it >> 2, h = it & 3;
    bf16_t* OA = (bf16_t*)(p.ws + WS_OA) + (size_t)(MP + s) * D + h * MHD;
    LAS float* sS = (LAS float*)lds;
    LAS float* sO = sS + 256;
    float q[8];
    { const float* PART = (const float*)(p.ws + WS_PART) + (size_t)s * D + h * MHD;
      f32x4 a = (f32x4){0.f, 0.f, 0.f, 0.f}, b = a;
#pragma unroll
      for (int sl = 0; sl < 8; ++sl) { a += *(const f32x4*)(PART + (size_t)sl * 128 * D + lane * 4); b += *(const f32x4*)(PART + (size_t)sl * 128 * D + 256 + lane * 4); }
#pragma unroll
      for (int j = 0; j < 4; ++j) { q[j] = a[j] * QSCALE; q[4 + j] = b[j] * QSCALE; } }
    const float* Kc = p.in[I_CK] + ((size_t)s * NMEM * NMH + h) * MHD;
    const float* Vc = p.in[I_CV] + ((size_t)s * NMEM * NMH + h) * MHD;
#pragma unroll 1
    for (int kb = 0; kb < 32; kb += 4) {
        f32x4 ka[4], kb4[4];
#pragma unroll
        for (int u = 0; u < 4; ++u) { const float* kr = Kc + (size_t)(wid * 32 + kb + u) * D; ka[u] = __builtin_nontemporal_load((const f32x4*)(kr + lane * 4)); kb4[u] = __builtin_nontemporal_load((const f32x4*)(kr + 256 + lane * 4)); }
#pragma unroll
        for (int u = 0; u < 4; ++u) {
            float d = ka[u][0] * q[0] + ka[u][1] * q[1] + ka[u][2] * q[2] + ka[u][3] * q[3] + kb4[u][0] * q[4] + kb4[u][1] * q[5] + kb4[u][2] * q[6] + kb4[u][3] * q[7];
            d = wave_sum(d);
            if (lane == 0) sS[wid * 32 + kb + u] = d;
        }
    }
    __syncthreads();
    {
        const float s0 = sS[lane], s1 = sS[lane + 64], s2 = sS[lane + 128], s3 = sS[lane + 192];
        const float mx = wave_max(fmaxf(fmaxf(s0, s1), fmaxf(s2, s3)));
        const float e0 = __expf(s0 - mx), e1 = __expf(s1 - mx), e2 = __expf(s2 - mx), e3 = __expf(s3 - mx);
        const float inv = 1.f / wave_sum((e0 + e1) + (e2 + e3));
        __syncthreads();
        if (wid == 0) { sS[lane] = e0 * inv; sS[lane + 64] = e1 * inv; sS[lane + 128] = e2 * inv; sS[lane + 192] = e3 * inv; }
    }
    __syncthreads();
    {
        const int g = tid >> 7, d4 = tid & 127;
        f32x4 o = (f32x4){0.f, 0.f, 0.f, 0.f};
#pragma unroll 1
        for (int kb = 0; kb < 64; kb += 8) {
            f32x4 vv[8];
#pragma unroll
            for (int u = 0; u < 8; ++u) vv[u] = __builtin_nontemporal_load((const f32x4*)(Vc + (size_t)(g * 64 + kb + u) * D + d4 * 4));
#pragma unroll
            for (int u = 0; u < 8; ++u) o += vv[u] * sS[g * 64 + kb + u];
        }
        *(LAS f32x4*)(sO + g * 512 + d4 * 4) = o;
    }
    __syncthreads();
    if (tid < 128) {
        const f32x4 o = (*(const LAS f32x4*)(sO + tid * 4) + *(const LAS f32x4*)(sO + 512 + tid * 4)) + (*(const LAS f32x4*)(sO + 1024 + tid * 4) + *(const LAS f32x4*)(sO + 1536 + tid * 4));
        *(u32x2*)(OA + tid * 4) = (u32x2){cvt_pk_bf16(o[0], o[1]), cvt_pk_bf16(o[2], o[3])};
    }
    __syncthreads();
}

#define XB_TMO      128
#define XB_XCNT(j)  (256  + 64 * (j))
#define XB_XSUB(j)  (1280 + 64 * (j))
#define XB_XGEN(j)  (2304 + 64 * (j))
#define XB_TOP      3328
#define XB_TOPGEN   3392
#define XCD_BAR_WORDS 3456
#define XB_SPIN_CAP (1u << 18)
__device__ __forceinline__ unsigned xb_ld(unsigned* p)              { return __hip_atomic_load(p, __ATOMIC_RELAXED, __HIP_MEMORY_SCOPE_AGENT); }
__device__ __forceinline__ unsigned xb_add(unsigned* p, unsigned v) { return __hip_atomic_fetch_add(p, v, __ATOMIC_RELAXED, __HIP_MEMORY_SCOPE_AGENT); }
__device__ __forceinline__ unsigned xb_xcc_id() { return (unsigned)__builtin_amdgcn_s_getreg((3 << 11) | 20) & 0xFu; }
#define XB_SPIN(cond, bar) do { unsigned _sp = 0; while (cond) { __builtin_amdgcn_s_sleep(1); \
    if ((++_sp & 255u) == 0u) { if (xb_ld(&(bar)[XB_TMO])) break; if (_sp > XB_SPIN_CAP) { atomicAdd(&(bar)[XB_TMO], 1u); break; } } } } while (0)
struct XcdBarrier { unsigned* bar; unsigned x; volatile LAS unsigned* st; };
__device__ __forceinline__ XcdBarrier xcd_barrier_post(unsigned* bar, volatile LAS unsigned* st) {
    XcdBarrier b; b.bar = bar; b.x = xb_xcc_id(); b.st = st;
    if (threadIdx.x == 0) (void)xb_add(&bar[XB_XCNT(b.x)], 1u);
    return b;
}
__device__ __forceinline__ void xcd_barrier_complete(unsigned* bar, unsigned x, unsigned& nloc, unsigned& nx) {
    const unsigned G = gridDim.x * gridDim.y * gridDim.z;
    unsigned sum, cnt, mine, sp = 0u;
    for (;;) {
        sum = 0u; cnt = 0u; mine = 0u;
#pragma unroll
        for (unsigned j = 0; j < 16; ++j) { const unsigned c = xb_ld(&bar[XB_XCNT(j)]); sum += c; cnt += (c > 0u) ? 1u : 0u; mine = (j == x) ? c : mine; }
        if (sum == G) break;
        __builtin_amdgcn_s_sleep(1);
        if ((++sp & 255u) == 0u) { if (xb_ld(&bar[XB_TMO])) break; if (sp > XB_SPIN_CAP) { atomicAdd(&bar[XB_TMO], 1u); break; } }
    }
    nloc = mine > 0u ? mine : 1u; nx = cnt > 0u ? cnt : 1u;
}
__device__ __forceinline__ void xcd_barrier(const XcdBarrier& b) {
    asm volatile("s_waitcnt vmcnt(0)" ::: "memory");
    __syncthreads();
    if (threadIdx.x == 0) {
        unsigned* bar = b.bar;
        __builtin_amdgcn_s_waitcnt(0);
        unsigned nloc = b.st[0], nx = b.st[1];
        if (nloc == 0u) { xcd_barrier_complete(bar, b.x, nloc, nx); b.st[0] = nloc; b.st[1] = nx; }
        const unsigned old = xb_add(&bar[XB_XSUB(b.x)], 1u);
        const unsigned gen = old / nloc;
        if (old + 1u == (gen + 1u) * nloc) {
            __builtin_amdgcn_fence(__ATOMIC_RELEASE, "agent");
            asm volatile("s_waitcnt vmcnt(0)" ::: "memory");
            const unsigned og = xb_add(&bar[XB_TOP], 1u);
            const unsigned tg = og / nx;
            if (og + 1u == (tg + 1u) * nx) xb_add(&bar[XB_TOPGEN], 1u);
            else XB_SPIN(xb_ld(&bar[XB_TOPGEN]) == tg, bar);
            __builtin_amdgcn_fence(__ATOMIC_ACQUIRE, "agent");
            xb_add(&bar[XB_XGEN(b.x)], 1u);
            asm volatile("s_waitcnt vmcnt(0)" ::: "memory");
        } else {
            XB_SPIN(xb_ld(&bar[XB_XGEN(b.x)]) == gen, bar);
            __builtin_amdgcn_fence(__ATOMIC_ACQUIRE, "agent");
            asm volatile("s_waitcnt vmcnt(0)" ::: "memory");
        }
    }
    __syncthreads();
}

__global__ void __launch_bounds__(512, 2) fwd_megakernel(Params p) {
    extern __shared__ __attribute__((aligned(16))) unsigned char lds_raw[];
    LAS unsigned char* lds = (LAS unsigned char*)lds_raw;
    cg::grid_group grid = cg::this_grid();
    const int G = gridDim.x, bid = blockIdx.x;
    unsigned char* ws = p.ws;
    const int lo = p.ph_lo, hi = p.ph_hi;
#define IN(k) (lo <= (k) && (k) < hi)
    volatile LAS unsigned* bst = (volatile LAS unsigned*)(lds + 131072);
    if (threadIdx.x < 2) bst[threadIdx.x] = 0u;
    __syncthreads();
    XcdBarrier xbar = xcd_barrier_post((unsigned*)(ws + WS_CTL), bst);
    if (p.ph_hi < 0) grid.sync();
#define SEAM(k) do { if (IN(k) && IN((k) + 1)) xcd_barrier(xbar); } while (0)
#define EXTRA_SYNC() xcd_barrier(xbar)
    bf16_t* XB = (bf16_t*)(ws + WS_XB); bf16_t* Z = (bf16_t*)(ws + WS_Z); float* XF = (float*)(ws + WS_XF);
    bf16_t* Hb = (bf16_t*)(ws + WS_RB);

    float* PART = (float*)(ws + WS_PART);
    if (IN(0)) { for (int _r = 0; _r <= ((DUPMASK >> 0) & 1); ++_r) { phase_prep(p, lds, G, bid);  if (_r < ((DUPMASK >> 0) & 1)) EXTRA_SYNC(); } } SEAM(0);
    if (IN(1)) { for (int _r = 0; _r <= ((DUPMASK >> 1) & 1); ++_r) {
        { SchedPlain S; S.init(XB, ws + WS_W13A, D, D, 33, 44, G, bid); EpiGluH E{Hb}; gemm_phase(lds, D, D, D, S, E); }
        { SchedPlain S; S.init(ws + WS_MEMB, ws + WS_WMK, D, D, 4, 16, G, G - 1 - bid); EpiMemKV E{p.out + O_MKP, p.out + O_MVP, (bf16_t*)(ws + WS_KB), (bf16_t*)(ws + WS_VT)}; gemm_phase(lds, D, D, D, S, E); }
     if (_r < ((DUPMASK >> 1) & 1)) EXTRA_SYNC(); } } SEAM(1);
    if (IN(2)) { for (int _r = 0; _r <= ((DUPMASK >> 2) & 1); ++_r) {
        { SchedPlain S; S.init(Hb, ws + WS_W2A, FF, FF, 32, 8, G, bid); EpiResidB E{Z, XB, 0.5f}; gemm_phase(lds, FF, FF, FF, S, E); }
        { SchedPieces S{(const char*)Hb, (const char*)(ws + WS_W2A), FF, FF, 8 * 22, G, bid}; EpiPart E{PART}; gemm_phase(lds, FF, FF, 256, S, E); }
     if (_r < ((DUPMASK >> 2) & 1)) EXTRA_SYNC(); } } SEAM(2);
    if (IN(3)) { for (int _r = 0; _r <= ((DUPMASK >> 3) & 1); ++_r) { phase_ln(lds, Z, p.in[I_LN1G], p.in[I_LN1B], nullptr, XB, G, bid, PART, 22, p.in[I_XS], nullptr, 0.5f);  if (_r < ((DUPMASK >> 3) & 1)) EXTRA_SYNC(); } } SEAM(3);
    if (IN(4)) { for (int _r = 0; _r <= ((DUPMASK >> 4) & 1); ++_r) {
        SchedPlain S; S.init(XB, ws + WS_WIN, D, D, 33, 22, G, bid); EpiWin E{(float*)(ws + WS_RA), (float*)(ws + WS_U)}; gemm_phase(lds, D, D, D, S, E);
     if (_r < ((DUPMASK >> 4) & 1)) EXTRA_SYNC(); } } SEAM(4);
    if (IN(5)) { for (int _r = 0; _r <= ((DUPMASK >> 5) & 1); ++_r) { phase_mixpre(p, G, bid);  if (_r < ((DUPMASK >> 5) & 1)) EXTRA_SYNC(); } } SEAM(5);
    if (IN(6)) { for (int _r = 0; _r <= ((DUPMASK >> 6) & 1); ++_r) {
        SchedPlain S; S.init(ws + WS_LA, ws + WS_WLORA, LK, LK, 33, 12, G, bid); EpiLora E{(float*)(ws + WS_RB), p.in[I_W0], p.in[I_A0]}; gemm_phase(lds, LK, LK, LK, S, E);
     if (_r < ((DUPMASK >> 6) & 1)) EXTRA_SYNC(); } } SEAM(6);
    if (IN(7)) { for (int _r = 0; _r <= ((DUPMASK >> 7) & 1); ++_r) { phase_scan(p, lds, G, bid);  if (_r < ((DUPMASK >> 7) & 1)) EXTRA_SYNC(); } } SEAM(7);
    if (IN(8)) { for (int _r = 0; _r <= ((DUPMASK >> 8) & 1); ++_r) { phase_mix2(p, lds, G, bid);  if (_r < ((DUPMASK >> 8) & 1)) EXTRA_SYNC(); } } SEAM(8);
    if (IN(9)) { for (int _r = 0; _r <= ((DUPMASK >> 9) & 1); ++_r) {
        { SchedPlain S; S.init(ws + WS_OMIX, ws + WS_WOUT, D, D, 32, 8, G, bid); EpiResidB E{Z, XB, 1.0f}; gemm_phase(lds, D, D, D, S, E); }
        { SchedPieces S{(const char*)(ws + WS_OMIX), (const char*)(ws + WS_WOUT), D, D, 8 * 8, G, bid}; EpiPart E{PART}; gemm_phase(lds, D, D, 256, S, E); }
     if (_r < ((DUPMASK >> 9) & 1)) EXTRA_SYNC(); } } SEAM(9);
    if (IN(10)) { for (int _r = 0; _r <= ((DUPMASK >> 10) & 1); ++_r) { phase_ln(lds, Z, p.in[I_LN2G], p.in[I_LN2B], nullptr, XB, G, bid, PART, 8, nullptr, XB + (size_t)MP * D, 1.0f);  if (_r < ((DUPMASK >> 10) & 1)) EXTRA_SYNC(); } } SEAM(10);
    if (IN(11)) { for (int _r = 0; _r <= ((DUPMASK >> 11) & 1); ++_r) {
        { SchedPlain S; S.init(XB, ws + WS_WMQ, D, D, 32, 8, G, bid); EpiBf16 E{(bf16_t*)(ws + WS_Q), D, QSCALE, MP}; gemm_phase(lds, D, D, D, S, E); }
        { SchedPieces S{(const char*)XB, (const char*)(ws + WS_WMQ), D, D, 8 * 8, G, bid}; EpiPart E{PART}; gemm_phase(lds, D, D, 256, S, E); }
     if (_r < ((DUPMASK >> 11) & 1)) EXTRA_SYNC(); } } SEAM(11);
    if (IN(12)) { for (int _r = 0; _r <= ((DUPMASK >> 12) & 1); ++_r) {
        { SchedScores S{(const char*)(ws + WS_Q), (const char*)(ws + WS_KB), G, bid}; EpiSoftmax E{(bf16_t*)(ws + WS_P)}; gemm_phase(lds, D, D, MHD, S, E); }
        for (int it = bid; it < MS * NMH; it += G) samp_attn_item(p, lds, it);
     if (_r < ((DUPMASK >> 12) & 1)) EXTRA_SYNC(); } } SEAM(12);
    if (IN(13)) { for (int _r = 0; _r <= ((DUPMASK >> 13) & 1); ++_r) {
        SchedPV S{(const char*)(ws + WS_P), (const char*)(ws + WS_VT), G, bid}; EpiBf16 E{(bf16_t*)(ws + WS_OA), D, 1.0f, MP}; gemm_phase(lds, 1024, NMEM, NMEM, S, E);
     if (_r < ((DUPMASK >> 13) & 1)) EXTRA_SYNC(); } } SEAM(13);
    if (IN(14)) { for (int _r = 0; _r <= ((DUPMASK >> 14) & 1); ++_r) {
        { SchedPlain S; S.init(ws + WS_OA, ws + WS_WMO, D, D, 32, 8, G, bid); EpiResidB E{Z, XB, 1.0f}; gemm_phase(lds, D, D, D, S, E); }
        { SchedPieces S{(const char*)(ws + WS_OA), (const char*)(ws + WS_WMO), D, D, 8 * 8, G, bid}; EpiPart E{PART}; gemm_phase(lds, D, D, 256, S, E); }
     if (_r < ((DUPMASK >> 14) & 1)) EXTRA_SYNC(); } } SEAM(14);
    if (IN(15)) { for (int _r = 0; _r <= ((DUPMASK >> 15) & 1); ++_r) { phase_ln(lds, Z, p.in[I_LN3G], p.in[I_LN3B], nullptr, XB, G, bid, PART, 8, nullptr, XB + (size_t)MP * D, 1.0f);  if (_r < ((DUPMASK >> 15) & 1)) EXTRA_SYNC(); } } SEAM(15);
    if (IN(16)) { for (int _r = 0; _r <= ((DUPMASK >> 16) & 1); ++_r) {
        SchedPlain S; S.init(XB, ws + WS_W13B, D, D, 33, 44, G, bid); EpiGluH E{Hb}; gemm_phase(lds, D, D, D, S, E);
     if (_r < ((DUPMASK >> 16) & 1)) EXTRA_SYNC(); } } SEAM(16);
    if (IN(17)) { for (int _r = 0; _r <= ((DUPMASK >> 17) & 1); ++_r) {
        { SchedPlain S; S.init(Hb, ws + WS_W2B, FF, FF, 32, 8, G, bid); EpiResidB E{Z, XB, 0.5f}; gemm_phase(lds, FF, FF, FF, S, E); }
        { SchedPieces S{(const char*)Hb, (const char*)(ws + WS_W2B), FF, FF, 8 * 22, G, bid}; EpiPart E{PART}; gemm_phase(lds, FF, FF, 256, S, E); }
     if (_r < ((DUPMASK >> 17) & 1)) EXTRA_SYNC(); } } SEAM(17);
    if (IN(18)) for (int _r = 0; _r <= ((DUPMASK >> 18) & 1); ++_r) { if (_r) EXTRA_SYNC(); phase_ln(lds, Z, p.in[I_LN4G], p.in[I_LN4B], p.out + O_Y, nullptr, G, bid, PART, 22, nullptr, XB + (size_t)MP * D, 0.5f); }
#undef IN
#undef SEAM
}

extern "C" void kernel_launch(void* const* d_in, const int* in_sizes, int n_in, void* d_out, int out_size, void* d_ws, size_t ws_size, hipStream_t stream) {
    static int grid = 0;
    if (grid == 0) {
        if (n_in != N_IN || (size_t)out_size != O_END || ws_size < WS_END) { fprintf(stderr, "kernel_launch: unexpected shapes: n_in %d out %d ws %zu (need %zu)\n", n_in, out_size, ws_size, (size_t)WS_END); grid = -1; return; }
        int dev = 0, cus = 0, per_cu = 0;
        if (hipGetDevice(&dev) != hipSuccess || hipDeviceGetAttribute(&cus, hipDeviceAttributeMultiprocessorCount, dev) != hipSuccess) { fprintf(stderr, "kernel_launch: device query failed\n"); grid = -1; return; }
        if (hipFuncSetAttribute((const void*)fwd_megakernel, hipFuncAttributeMaxDynamicSharedMemorySize, LDS_BYTES) != hipSuccess) { fprintf(stderr, "kernel_launch: hipFuncSetAttribute failed\n"); grid = -1; return; }
        if (hipOccupancyMaxActiveBlocksPerMultiprocessor(&per_cu, (const void*)fwd_megakernel, 512, LDS_BYTES) != hipSuccess || per_cu < 1) { fprintf(stderr, "kernel_launch: occupancy query gives %d\n", per_cu); (void)hipGetLastError(); per_cu = 1; }
        grid = cus * 1;
        if (grid < 128) { fprintf(stderr, "kernel_launch: grid %d too small\n", grid); grid = -1; return; }
    }
    if (grid < 0) return;
    Params p{};
    for (int i = 0; i < N_IN; ++i) p.in[i] = (const float*)d_in[i];
    p.out = (float*)d_out; p.ws = (unsigned char*)d_ws; p.ph_lo = 0; p.ph_hi = NPHASE;
    if (hipMemsetAsync((char*)d_ws + WS_CTL, 0, 16384, stream) != hipSuccess) { fprintf(stderr, "kernel_launch: memset of the barrier words failed\n"); return; }
    void* args[] = {&p};
    hipError_t e = hipLaunchCooperativeKernel((const void*)fwd_megakernel, dim3(grid), dim3(512), args, LDS_BYTES, stream);
    if (e != hipSuccess) fprintf(stderr, "cooperative launch failed: %s (grid %d)\n", hipGetErrorString(e), grid);
}
```

```cpp
#ifndef DUPMASK
#define DUPMASK 0
#endif
#include <hip/hip_runtime.h>
#include <hip/hip_cooperative_groups.h>
#include <cstdio>
#include <cstdint>
namespace cg = cooperative_groups;

#define LAS __attribute__((address_space(3)))
typedef unsigned short bf16_t;
typedef short bf16x8 __attribute__((ext_vector_type(8)));
typedef float f32x4 __attribute__((ext_vector_type(4)));
typedef float f32x2 __attribute__((ext_vector_type(2)));
typedef unsigned u32x4 __attribute__((ext_vector_type(4)));
typedef unsigned u32x2 __attribute__((ext_vector_type(2)));

constexpr int D = 2048, MP = 8192, MS = 128, M = MP + MS, MPAD = 8448, SEQ = 2048, NB = 4;
constexpr int FF = 5632, SC = 3360, DR = 1024, DC = 1024, NH = 16, HD = 64;
constexpr int NMEM = 256, NMH = 4, MHD = 512, CW = 31, LK = 384;
constexpr float ALPHA = 1.189207115002721f;
constexpr float LN_EPS = 1e-5f, GN_EPS = 64e-5f;
constexpr float QSCALE = 0.044194173824159216f;

enum { I_XP = 0, I_XS, I_MEM, I_SSH, I_SCV, I_SWKV, I_CK, I_CV, I_F1W1, I_F1W3, I_F1W2, I_LN1G, I_LN1B, I_WIN, I_MU, I_W0, I_W2D, I_A0, I_A2, I_G2,
       I_KK, I_KA, I_RK, I_GNG, I_GNB, I_CVW, I_CVB, I_CLG, I_CLB, I_BR, I_BC, I_WOUT, I_LN2G, I_LN2B, I_WMQ, I_WMK, I_WMV, I_WMO, I_LN3G, I_LN3B,
       I_F2W1, I_F2W3, I_F2W2, I_LN4G, I_LN4B, N_IN };
constexpr size_t O_Y = 0, O_SHP = (size_t)M * D, O_CVP = O_SHP + (size_t)NB * SC, O_WKP = O_CVP + (size_t)NB * 30 * DC, O_MKP = O_WKP + (size_t)NB * NH * HD * HD,
                 O_MVP = O_MKP + (size_t)NB * NMEM * D, O_SHS = O_MVP + (size_t)NB * NMEM * D, O_CVS = O_SHS + (size_t)MS * SC, O_WKS = O_CVS + (size_t)MS * 30 * DC,
                 O_END = O_WKS + (size_t)MS * NH * HD * HD;
constexpr size_t MiB = 1u << 20;
constexpr size_t WS_W13A = 0, WS_W2A = WS_W13A + 44 * MiB, WS_WIN = WS_W2A + 22 * MiB, WS_WOUT = WS_WIN + 22 * MiB, WS_WMQ = WS_WOUT + 8 * MiB, WS_WMK = WS_WMQ + 8 * MiB,
                 WS_WMV = WS_WMK + 8 * MiB, WS_WMO = WS_WMV + 8 * MiB, WS_W13B = WS_WMO + 8 * MiB, WS_W2B = WS_W13B + 44 * MiB, WS_WLORA = WS_W2B + 22 * MiB,
                 WS_XB = WS_WLORA + 3 * MiB,
                 WS_Z = WS_XB + 33 * MiB,
                 WS_XF = WS_Z + 65 * MiB,
                 WS_RA = WS_XF + 65 * MiB,
                 WS_RB = WS_RA + 107 * MiB,
                 WS_RKV = WS_RB + 98 * MiB,
                 WS_U = WS_RKV + 98 * MiB,
                 WS_LA = WS_U + 33 * MiB,
                 WS_OMIX = WS_LA + 7 * MiB,
                 WS_MEMB = WS_OMIX + 33 * MiB,
                 WS_KB = WS_MEMB + 4 * MiB,
                 WS_VT = WS_KB + 4 * MiB,
                 WS_PART = WS_VT + 4 * MiB,
                 WS_CTL = WS_PART + 23 * MiB,
                 WS_END = WS_CTL + 1 * MiB;
constexpr size_t WS_Y = WS_RKV;
constexpr size_t WS_Q = WS_RA, WS_P = WS_RA + 33 * MiB, WS_OA = WS_RA + 50 * MiB;

constexpr int LDS_BYTES = 131072 + 2048;
constexpr int NPHASE = 19;

struct Params { const float* in[N_IN]; float* out; unsigned char* ws; int ph_lo, ph_hi; };

__device__ __forceinline__ unsigned cvt_pk_bf16(float lo, float hi) { unsigned r; asm("v_cvt_pk_bf16_f32 %0, %1, %2" : "=v"(r) : "v"(lo), "v"(hi)); return r; }
__device__ __forceinline__ bf16_t f2bf(float f) { return (bf16_t)(cvt_pk_bf16(f, f) & 0xffffu); }
__device__ __forceinline__ float bf2f(bf16_t b) { return __builtin_bit_cast(float, (unsigned)b << 16); }
template <int C> __device__ __forceinline__ float dppf(float v) { return __builtin_bit_cast(float, __builtin_amdgcn_update_dpp(0, __builtin_bit_cast(int, v), C, 0xF, 0xF, true)); }
__device__ __forceinline__ float red8(float x) { x += dppf<0xB1>(x); x += dppf<0x4E>(x); x += dppf<0x141>(x); return x; }
__device__ __forceinline__ float red16(float x) { x += dppf<0xB1>(x); x += dppf<0x4E>(x); x += dppf<0x141>(x); x += dppf<0x140>(x); return x; }
__device__ __forceinline__ float swap16_sum(float x) { float a = x, b = x; asm volatile("s_nop 1\n\tv_permlane16_swap_b32 %0, %1" : "+v"(a), "+v"(b)); return a + b; }
__device__ __forceinline__ float swap32_sum(float x) { float a = x, b = x; asm volatile("s_nop 1\n\tv_permlane32_swap_b32 %0, %1" : "+v"(a), "+v"(b)); return a + b; }
__device__ __forceinline__ float wave_sum(float v) { return swap32_sum(swap16_sum(red16(v))); }
__device__ __forceinline__ float wave_max(float v) {
#pragma unroll
    for (int o = 1; o < 64; o <<= 1) v = fmaxf(v, __shfl_xor(v, o));
    return v;
}
__device__ __forceinline__ float sigmoid_f(float x) { return __builtin_amdgcn_rcpf(1.f + __expf(-x)); }
__device__ __forceinline__ float silu_f(float x) { return x * __builtin_amdgcn_rcpf(1.f + __expf(-x)); }

constexpr int BK = 64, HALF = 128, HTB = HALF * BK * 2;
__device__ __forceinline__ int lds_byte(int r, int c) { const int st = (r >> 4) * 2 + (c >> 5), rr = r & 15, cc = c & 31, ob = rr * 64 + cc * 2; return st * 1024 + (ob ^ (((ob >> 9) & 1) << 5)); }
__device__ __forceinline__ void stage_rc(int b, int& R, int& C) { const int st = b / 1024, sb = b % 1024, swz = sb ^ (((sb >> 9) & 1) << 5); R = (st >> 1) * 16 + swz / 64; C = (st & 1) * 32 + (swz % 64) / 2; }
__device__ __forceinline__ int perm32(int rho) { const int n = rho >> 4, i = rho & 15; return 8 * (i >> 2) + 4 * n + (i & 3); }

struct Unit { const char* A; const char* B; int r0, c0, tn; };
typedef f32x4 Acc[2][2][4][2];

struct SchedPlain {
    const char* A; const char* B; int lda, ldb, nM, nN, nwg, G, c;
    __device__ __forceinline__ void init(const void* A_, const void* B_, int lda_, int ldb_, int nM_, int nN_, int G_, int c_) { A = (const char*)A_; B = (const char*)B_; lda = lda_; ldb = ldb_; nM = nM_; nN = nN_; nwg = nM_ * nN_; G = G_; c = c_; }
    __device__ __forceinline__ bool next(int i, Unit& u) const {
        const long L = (long)i * G + c; if (L >= nwg) return false;
        int wgid = (int)L; { const int q = nwg / 8, r = nwg % 8, xcd = wgid % 8, off = wgid / 8; wgid = (xcd < r ? xcd * (q + 1) : r * (q + 1) + (xcd - r) * q) + off; }
        const int nig = 8 * nN, gid = wgid / nig, fm = gid * 8, gsz = (nM - fm) < 8 ? (nM - fm) : 8;
        const int pm = fm + ((wgid % nig) % gsz), pn = (wgid % nig) / gsz;
        u.A = A + (size_t)pm * 256 * lda * 2; u.B = B + (size_t)pn * 256 * ldb * 2; u.r0 = pm * 256; u.c0 = pn * 256; u.tn = pn; return true;
    }
};
struct SchedScores {
    const char* Q; const char* KB; int G, c;
    __device__ __forceinline__ bool next(int i, Unit& u) const {
        const long L = (long)i * G + c; if (L >= 128) return false;
        const int z = (int)L >> 3, pm = (int)L & 7, b = z >> 2, h = z & 3;
        u.A = Q + ((size_t)(b * SEQ + pm * 256) * D + h * MHD) * 2; u.B = KB + ((size_t)(b * NMEM) * D + h * MHD) * 2; u.r0 = b * SEQ + pm * 256; u.c0 = h * NMEM; u.tn = 0; return true;
    }
};
struct SchedPV {
    const char* P; const char* VT; int G, c;
    __device__ __forceinline__ bool next(int i, Unit& u) const {
        const long L = (long)i * G + c; if (L >= 256) return false;
        const int z = (int)L >> 4, pm = ((int)L & 15) >> 1, pn = (int)L & 1, b = z >> 2, h = z & 3;
        u.A = P + ((size_t)(b * SEQ + pm * 256) * 1024 + h * NMEM) * 2; u.B = VT + ((size_t)(b * D + h * MHD + pn * 256) * NMEM) * 2; u.r0 = b * SEQ + pm * 256; u.c0 = h * MHD + pn * 256; u.tn = pn; return true;
    }
};

struct SchedPieces {
    const char* A; const char* B; int lda, ldb, total, G, c;
    __device__ __forceinline__ bool next(int i, Unit& u) const {
        const long L = (long)i * G + c; if (L >= total) return false;
        const int pn = (int)L & 7, sl = (int)L >> 3;
        u.A = A + ((size_t)MP * lda + sl * 256) * 2; u.B = B + ((size_t)pn * 256 * ldb + sl * 256) * 2; u.r0 = MP; u.c0 = pn * 256; u.tn = sl; return true;
    }
};

template <class Epi, class Sched>
__device__ __forceinline__ void gemm_phase(LAS unsigned char* lds, const int lda, const int ldb, const int K, const Sched& S, const Epi& E) {
    const int tid = threadIdx.x, wid = __builtin_amdgcn_readfirstlane(tid >> 6), lane = tid & 63, wr = wid >> 2, wc = wid & 3, fr = lane & 15, fq = lane >> 4;
    const int nt = K / BK;
    unsigned voffA[2], voffB[2];
#pragma unroll
    for (int i = 0; i < 2; ++i) { int R, C; stage_rc(tid * 16 + i * 8192, R, C); const int Rb = (R & ~31) + perm32(R & 31);
        voffA[i] = (unsigned)(R * lda + C) * 2u; voffB[i] = (unsigned)(Rb * ldb + C) * 2u; }
    const size_t kstep = (size_t)(BK * 2);
    const size_t hstepA = (size_t)HALF * lda * 2, hstepB = (size_t)HALF * ldb * 2;
    const unsigned ldsw = (unsigned)wid * 1024u;
    const int aoff = lds_byte(wr * 64 + fr, fq * 8), boff = lds_byte(wc * 32 + fr, fq * 8);
#define G_SA(b, h) (((b) * 2 + (h)) * HTB)
#define G_SB(b, h) ((4 + (b) * 2 + (h)) * HTB)
#define G_STAGE(bufoff, gbase, voff) do { _Pragma("unroll") for (int _i = 0; _i < 2; ++_i) \
        __builtin_amdgcn_global_load_lds((const unsigned*)((const char*)(gbase) + (voff)[_i]), (LAS unsigned*)(lds + (bufoff) + ldsw + _i * 8192), 16, 0, 0); } while (0)
#define G_LDA(dst, b, h) do { _Pragma("unroll") for (int m = 0; m < 4; ++m) _Pragma("unroll") for (int k = 0; k < 2; ++k) dst[m][k] = *(const LAS bf16x8*)(lds + G_SA(b, h) + aoff + m * 2048 + k * 1024); } while (0)
#define G_LDB(dst, b, h) do { _Pragma("unroll") for (int n = 0; n < 2; ++n) _Pragma("unroll") for (int k = 0; k < 2; ++k) dst[n][k] = *(const LAS bf16x8*)(lds + G_SB(b, h) + boff + n * 2048 + k * 1024); } while (0)
#define G_MMA(ai, bj, At, Bt) do { __builtin_amdgcn_s_setprio(1); _Pragma("unroll") for (int m = 0; m < 4; ++m) _Pragma("unroll") for (int n = 0; n < 2; ++n) _Pragma("unroll") for (int k = 0; k < 2; ++k) \
        acc[ai][bj][m][n] = __builtin_amdgcn_mfma_f32_16x16x32_bf16(Bt[n][k], At[m][k], acc[ai][bj][m][n], 0, 0, 0); __builtin_amdgcn_s_setprio(0); } while (0)
#define G_WAIT_V(n) asm volatile("s_waitcnt vmcnt(" #n ")" ::: "memory")
#define G_WAIT_L(n) asm volatile("s_waitcnt lgkmcnt(" #n ")" ::: "memory")
#define G_BAR __builtin_amdgcn_s_barrier()
#define G_SCHED __builtin_amdgcn_sched_barrier(0)
    Unit cur, nxt; int ui = 0;
    if (!S.next(0, cur)) return;
    Acc acc;
#pragma unroll
    for (int a = 0; a < 2; ++a)
#pragma unroll
        for (int b = 0; b < 2; ++b)
#pragma unroll
            for (int m = 0; m < 4; ++m)
#pragma unroll
                for (int n = 0; n < 2; ++n) acc[a][b][m][n] = (f32x4){0.f, 0.f, 0.f, 0.f};
    bf16x8 At[4][2], B0[2][2], B1[2][2];
    const char* cA = cur.A; const char* cB = cur.B;
    G_STAGE(G_SB(0, 0), cB, voffB); G_STAGE(G_SB(0, 1), cB + hstepB, voffB); G_STAGE(G_SA(0, 0), cA, voffA); G_STAGE(G_SA(0, 1), cA + hstepA, voffA);
    if (wr == 1) G_BAR;
    G_WAIT_V(2); G_BAR;
    G_STAGE(G_SB(1, 0), cB + kstep, voffB); G_STAGE(G_SA(1, 0), cA + kstep, voffA); G_STAGE(G_SB(1, 1), cB + hstepB + kstep, voffB);
    G_WAIT_V(6); G_BAR;
    for (;;) {
        const bool has_next = S.next(ui + 1, nxt);
        const char* nA = has_next ? nxt.A : cA; const char* nB = has_next ? nxt.B : cB;
#pragma unroll 1
        for (int t = 0; t < nt; t += 2) {
            const bool last = (t == nt - 2);
            const char* a1 = cA + (size_t)(t + 1) * kstep;
            const char* a2 = last ? nA : cA + (size_t)(t + 2) * kstep; const char* b2 = last ? nB : cB + (size_t)(t + 2) * kstep;
            const char* a3 = a2 + kstep; const char* b3 = b2 + kstep;
            G_LDB(B0, 0, 0); G_LDB(B1, 0, 1); G_SCHED; G_LDA(At, 0, 0); G_STAGE(G_SA(1, 1), a1 + hstepA, voffA);
            G_WAIT_V(8); G_WAIT_L(0); G_BAR; G_MMA(0, 0, At, B0); G_MMA(0, 1, At, B1); G_BAR; G_SCHED;
            G_LDA(At, 0, 1); G_STAGE(G_SB(0, 0), b2, voffB); G_STAGE(G_SB(0, 1), b2 + hstepB, voffB); G_STAGE(G_SA(0, 0), a2, voffA);
            G_WAIT_V(8); G_WAIT_L(0); G_BAR; G_MMA(1, 0, At, B0); G_MMA(1, 1, At, B1); G_BAR; G_SCHED;
            G_LDB(B0, 1, 0); G_LDB(B1, 1, 1); G_SCHED; G_LDA(At, 1, 0); G_STAGE(G_SA(0, 1), a2 + hstepA, voffA);
            G_WAIT_V(8); G_WAIT_L(0); G_BAR; G_MMA(0, 0, At, B0); G_MMA(0, 1, At, B1); G_BAR; G_SCHED;
            G_LDA(At, 1, 1); G_STAGE(G_SB(1, 0), b3, voffB); G_STAGE(G_SB(1, 1), b3 + hstepB, voffB); G_STAGE(G_SA(1, 0), a3, voffA);
            G_WAIT_V(8); G_WAIT_L(0); G_BAR; G_MMA(1, 0, At, B0); G_MMA(1, 1, At, B1); G_BAR; G_SCHED;
        }
        if (wr == 0) G_BAR;
        if constexpr (!Epi::AFTER_DRAIN) E(acc, cur, wr, wc, fr, fq);
        if (!has_next) break;
#pragma unroll
        for (int a = 0; a < 2; ++a)
#pragma unroll
            for (int b = 0; b < 2; ++b)
#pragma unroll
                for (int m = 0; m < 4; ++m)
#pragma unroll
                    for (int n = 0; n < 2; ++n) acc[a][b][m][n] = (f32x4){0.f, 0.f, 0.f, 0.f};
        cur = nxt; cA = nA; cB = nB; ++ui;
        if (wr == 1) G_BAR;
    }
    G_WAIT_V(0);
    G_BAR;
    if constexpr (Epi::AFTER_DRAIN) E.fused(acc, cur, wr, wc, fr, fq, lds);
#undef G_SA
#undef G_SB
#undef G_STAGE
#undef G_LDA
#undef G_LDB
#undef G_MMA
#undef G_WAIT_V
#undef G_WAIT_L
#undef G_BAR
#undef G_SCHED
}

struct EpiGluH {
    static constexpr bool AFTER_DRAIN = false;
    bf16_t* H;
    __device__ __forceinline__ void operator()(Acc& acc, const Unit& u, int wr, int wc, int fr, int fq) const {
#pragma unroll
        for (int ai = 0; ai < 2; ++ai)
#pragma unroll
            for (int m = 0; m < 4; ++m) {
                const int r = u.r0 + 128 * ai + 64 * wr + 16 * m + fr;
                if (r < M) {
                    float h[8];
#pragma unroll
                    for (int n = 0; n < 2; ++n)
#pragma unroll
                        for (int j = 0; j < 4; ++j) h[4 * n + j] = silu_f(acc[ai][0][m][n][j]) * acc[ai][1][m][n][j];
                    u32x4 w; w.x = cvt_pk_bf16(h[0], h[1]); w.y = cvt_pk_bf16(h[2], h[3]); w.z = cvt_pk_bf16(h[4], h[5]); w.w = cvt_pk_bf16(h[6], h[7]);
                    *(u32x4*)(H + (size_t)r * FF + 128 * u.tn + 32 * wc + 8 * fq) = w;
                }
            }
    }
};
struct EpiResid {
    static constexpr bool AFTER_DRAIN = false;
    bf16_t* Z; const float* res0; const float* res1; float scale;
    __device__ __forceinline__ void operator()(Acc& acc, const Unit& u, int wr, int wc, int fr, int fq) const {
#pragma unroll
        for (int ai = 0; ai < 2; ++ai)
#pragma unroll
            for (int m = 0; m < 4; ++m) {
                const int r = u.r0 + 128 * ai + 64 * wr + 16 * m + fr;
                if (r < M) {
                    const float* rp = (r < MP) ? res0 + (size_t)r * D : res1 + (size_t)(r - MP) * D;
                    bf16_t* zp = Z + (size_t)r * D;
#pragma unroll
                    for (int bj = 0; bj < 2; ++bj) {
                        const int c = u.c0 + 128 * bj + 32 * wc + 8 * fq;
                        const f32x4 v0 = *(const f32x4*)(rp + c) * ALPHA + acc[ai][bj][m][0] * scale, v1 = *(const f32x4*)(rp + c + 4) * ALPHA + acc[ai][bj][m][1] * scale;
                        u32x4 w; w.x = cvt_pk_bf16(v0[0], v0[1]); w.y = cvt_pk_bf16(v0[2], v0[3]); w.z = cvt_pk_bf16(v1[0], v1[1]); w.w = cvt_pk_bf16(v1[2], v1[3]);
                        *(u32x4*)(zp + c) = w;
                    }
                }
            }
    }
};
struct EpiResidB {
    static constexpr bool AFTER_DRAIN = false;
    bf16_t* Z; const bf16_t* res; float scale;
    __device__ __forceinline__ void operator()(Acc& acc, const Unit& u, int wr, int wc, int fr, int fq) const {
#pragma unroll
        for (int ai = 0; ai < 2; ++ai)
#pragma unroll
            for (int m = 0; m < 4; ++m) {
                const int r = u.r0 + 128 * ai + 64 * wr + 16 * m + fr;
                const bf16_t* rp = res + (size_t)r * D; bf16_t* zp = Z + (size_t)r * D;
#pragma unroll
                for (int bj = 0; bj < 2; ++bj) {
                    const int c = u.c0 + 128 * bj + 32 * wc + 8 * fq;
                    const u32x4 rb = *(const u32x4*)(rp + c);
                    f32x4 r0, r1;
                    r0[0] = __builtin_bit_cast(float, rb[0] << 16); r0[1] = __builtin_bit_cast(float, rb[0] & 0xffff0000u); r0[2] = __builtin_bit_cast(float, rb[1] << 16); r0[3] = __builtin_bit_cast(float, rb[1] & 0xffff0000u);
                    r1[0] = __builtin_bit_cast(float, rb[2] << 16); r1[1] = __builtin_bit_cast(float, rb[2] & 0xffff0000u); r1[2] = __builtin_bit_cast(float, rb[3] << 16); r1[3] = __builtin_bit_cast(float, rb[3] & 0xffff0000u);
                    const f32x4 v0 = r0 * ALPHA + acc[ai][bj][m][0] * scale, v1 = r1 * ALPHA + acc[ai][bj][m][1] * scale;
                    u32x4 w; w.x = cvt_pk_bf16(v0[0], v0[1]); w.y = cvt_pk_bf16(v0[2], v0[3]); w.z = cvt_pk_bf16(v1[0], v1[1]); w.w = cvt_pk_bf16(v1[2], v1[3]);
                    *(u32x4*)(zp + c) = w;
                }
            }
    }
};
struct EpiPart {
    static constexpr bool AFTER_DRAIN = false;
    float* PART;
    __device__ __forceinline__ void operator()(Acc& acc, const Unit& u, int wr, int wc, int fr, int fq) const {
#pragma unroll
        for (int m = 0; m < 4; ++m) {
            const int rl = 64 * wr + 16 * m + fr;
            float* pp = PART + ((size_t)u.tn * 128 + rl) * D;
#pragma unroll
            for (int bj = 0; bj < 2; ++bj)
#pragma unroll
                for (int n = 0; n < 2; ++n) *(f32x4*)(pp + u.c0 + 128 * bj + 32 * wc + 8 * fq + 4 * n) = acc[0][bj][m][n];
        }
    }
};
struct EpiWin {
    static constexpr bool AFTER_DRAIN = false;
    float* PS; float* U;
    __device__ __forceinline__ void operator()(Acc& acc, const Unit& u, int wr, int wc, int fr, int fq) const {
#pragma unroll
        for (int ai = 0; ai < 2; ++ai)
#pragma unroll
            for (int m = 0; m < 4; ++m) {
                const int r = u.r0 + 128 * ai + 64 * wr + 16 * m + fr;
                if (r < M) {
                    if (u.tn < 14) {
#pragma unroll
                        for (int bj = 0; bj < 2; ++bj)
#pragma unroll
                            for (int n = 0; n < 2; ++n) {
                                const int c = u.c0 + 128 * bj + 32 * wc + 8 * fq + 4 * n;
                                if (c < SC) *(f32x4*)(PS + (size_t)r * SC + c) = acc[ai][bj][m][n];
                            }
                    } else {
#pragma unroll
                        for (int n = 0; n < 2; ++n) {
                            const int c = 128 * (u.tn - 14) + 32 * wc + 8 * fq + 4 * n;
                            f32x4 o;
#pragma unroll
                            for (int j = 0; j < 4; ++j) o[j] = acc[ai][0][m][n][j] * sigmoid_f(acc[ai][1][m][n][j]);
                            *(f32x4*)(U + (size_t)r * DC + c) = o;
                        }
                    }
                }
            }
    }
};
struct EpiLora {
    static constexpr bool AFTER_DRAIN = false;
    float* DAG; const float* w0; const float* a0;
    __device__ __forceinline__ void operator()(Acc& acc, const Unit& u, int wr, int wc, int fr, int fq) const {
        const int sec = u.tn >> 2;
#pragma unroll
        for (int ai = 0; ai < 2; ++ai)
#pragma unroll
            for (int m = 0; m < 4; ++m) {
                const int r = u.r0 + 128 * ai + 64 * wr + 16 * m + fr;
                if (r < M) {
#pragma unroll
                    for (int bj = 0; bj < 2; ++bj)
#pragma unroll
                        for (int n = 0; n < 2; ++n) {
                            const int c = u.c0 + 128 * bj + 32 * wc + 8 * fq + 4 * n, cc = c & 1023;
                            f32x4 o = acc[ai][bj][m][n];
                            if (sec == 0) {
                                const f32x4 wv = *(const f32x4*)(w0 + cc);
#pragma unroll
                                for (int j = 0; j < 4; ++j) o[j] = __expf(-0.6065306597126334f * sigmoid_f(wv[j] + o[j]));
                            } else if (sec == 1) {
                                const f32x4 av = *(const f32x4*)(a0 + cc);
#pragma unroll
                                for (int j = 0; j < 4; ++j) o[j] = sigmoid_f(av[j] + o[j]);
                            }
                            *(f32x4*)(DAG + (size_t)r * 3072 + c) = o;
                        }
                }
            }
    }
};
struct EpiBf16 {
    static constexpr bool AFTER_DRAIN = false;
    bf16_t* O; int ldc; float scale; int rlim;
    __device__ __forceinline__ void operator()(Acc& acc, const Unit& u, int wr, int wc, int fr, int fq) const {
#pragma unroll
        for (int ai = 0; ai < 2; ++ai)
#pragma unroll
            for (int m = 0; m < 4; ++m) {
                const int r = u.r0 + 128 * ai + 64 * wr + 16 * m + fr;
                if (r < rlim) {
#pragma unroll
                    for (int bj = 0; bj < 2; ++bj) {
                        const f32x4 v0 = acc[ai][bj][m][0] * scale, v1 = acc[ai][bj][m][1] * scale;
                        u32x4 w; w.x = cvt_pk_bf16(v0[0], v0[1]); w.y = cvt_pk_bf16(v0[2], v0[3]); w.z = cvt_pk_bf16(v1[0], v1[1]); w.w = cvt_pk_bf16(v1[2], v1[3]);
                        *(u32x4*)(O + (size_t)r * ldc + u.c0 + 128 * bj + 32 * wc + 8 * fq) = w;
                    }
                }
            }
    }
};
struct EpiMemKV {
    static constexpr bool AFTER_DRAIN = false;
    float* outK; float* outV; bf16_t* KB; bf16_t* VT;
    __device__ __forceinline__ void operator()(Acc& acc, const Unit& u, int wr, int wc, int fr, int fq) const {
#pragma unroll
        for (int ai = 0; ai < 2; ++ai)
#pragma unroll
            for (int m = 0; m < 4; ++m) {
                const int r = u.r0 + 128 * ai + 64 * wr + 16 * m + fr;
#pragma unroll
                for (int bj = 0; bj < 2; ++bj) {
                    const int c = u.c0 + 128 * bj + 32 * wc + 8 * fq;
                    const f32x4 v0 = acc[ai][bj][m][0], v1 = acc[ai][bj][m][1];
                    if (u.tn < 8) {
                        *(f32x4*)(outK + (size_t)r * D + c) = v0; *(f32x4*)(outK + (size_t)r * D + c + 4) = v1;
                        u32x4 w; w.x = cvt_pk_bf16(v0[0], v0[1]); w.y = cvt_pk_bf16(v0[2], v0[3]); w.z = cvt_pk_bf16(v1[0], v1[1]); w.w = cvt_pk_bf16(v1[2], v1[3]);
                        *(u32x4*)(KB + (size_t)r * D + c) = w;
                    } else {
                        const int cv = c - D;
                        *(f32x4*)(outV + (size_t)r * D + cv) = v0; *(f32x4*)(outV + (size_t)r * D + cv + 4) = v1;
                        bf16_t* vt = VT + ((size_t)(r >> 8) * D + cv) * NMEM + (r & 255);
#pragma unroll
                        for (int j = 0; j < 4; ++j) { vt[(size_t)j * NMEM] = f2bf(v0[j]); vt[(size_t)(4 + j) * NMEM] = f2bf(v1[j]); }
                    }
                }
            }
    }
};
struct EpiSoftmax {
    static constexpr bool AFTER_DRAIN = true;
    bf16_t* P;
    __device__ __forceinline__ void operator()(Acc&, const Unit&, int, int, int, int) const {}
    __device__ __forceinline__ void fused(Acc& acc, const Unit& u, int wr, int wc, int fr, int fq, LAS unsigned char* lds) const {
        LAS float* red = (LAS float*)lds;
        LAS float* red2 = red + 1024;
#pragma unroll
        for (int ai = 0; ai < 2; ++ai)
#pragma unroll
            for (int m = 0; m < 4; ++m) {
                float v = -3.0e38f;
#pragma unroll
                for (int bj = 0; bj < 2; ++bj)
#pragma unroll
                    for (int n = 0; n < 2; ++n)
#pragma unroll
                        for (int j = 0; j < 4; ++j) v = fmaxf(v, acc[ai][bj][m][n][j]);
                v = fmaxf(v, __shfl_xor(v, 16)); v = fmaxf(v, __shfl_xor(v, 32));
                if (fq == 0) red[wc * 256 + 128 * ai + 64 * wr + 16 * m + fr] = v;
            }
        __syncthreads();
#pragma unroll
        for (int ai = 0; ai < 2; ++ai)
#pragma unroll
            for (int m = 0; m < 4; ++m) {
                const int rl = 128 * ai + 64 * wr + 16 * m + fr;
                const float mx = fmaxf(fmaxf(red[rl], red[256 + rl]), fmaxf(red[512 + rl], red[768 + rl]));
                float s = 0.f;
#pragma unroll
                for (int bj = 0; bj < 2; ++bj)
#pragma unroll
                    for (int n = 0; n < 2; ++n)
#pragma unroll
                        for (int j = 0; j < 4; ++j) { const float e = __expf(acc[ai][bj][m][n][j] - mx); acc[ai][bj][m][n][j] = e; s += e; }
                s += __shfl_xor(s, 16); s += __shfl_xor(s, 32);
                if (fq == 0) red2[wc * 256 + rl] = s;
            }
        __syncthreads();
#pragma unroll
        for (int ai = 0; ai < 2; ++ai)
#pragma unroll
            for (int m = 0; m < 4; ++m) {
                const int rl = 128 * ai + 64 * wr + 16 * m + fr;
                const float inv = 1.f / ((red2[rl] + red2[256 + rl]) + (red2[512 + rl] + red2[768 + rl]));
#pragma unroll
                for (int bj = 0; bj < 2; ++bj) {
                    const f32x4 v0 = acc[ai][bj][m][0] * inv, v1 = acc[ai][bj][m][1] * inv;
                    u32x4 w; w.x = cvt_pk_bf16(v0[0], v0[1]); w.y = cvt_pk_bf16(v0[2], v0[3]); w.z = cvt_pk_bf16(v1[0], v1[1]); w.w = cvt_pk_bf16(v1[2], v1[3]);
                    *(u32x4*)(P + (size_t)(u.r0 + rl) * 1024 + u.c0 + 128 * bj + 32 * wc + 8 * fq) = w;
                }
            }
        __syncthreads();
    }
};

__device__ __forceinline__ void transpose_item(const float* W, int K, int N, bf16_t* WT, int k0, int n0, int drow0, LAS float* scr, int lane, bool late = false) {
    float tv[32];
#pragma unroll
    for (int i = 0; i < 32; ++i) tv[i] = __builtin_nontemporal_load(W + (size_t)(k0 + 2 * i + (lane >> 5)) * N + n0 + (lane & 31));
#pragma unroll
    for (int i = 0; i < 32; ++i) scr[(2 * i + (lane >> 5)) * 33 + (lane & 31)] = tv[i];
    asm volatile("s_waitcnt lgkmcnt(0)" ::: "memory");
    const int c = lane & 7;
#pragma unroll
    for (int j = 0; j < 4; ++j) { const int n = (lane >> 3) + 8 * j; const LAS float* s = scr + (8 * c) * 33 + n;
        u32x4 o; o.x = cvt_pk_bf16(s[0 * 33], s[1 * 33]); o.y = cvt_pk_bf16(s[2 * 33], s[3 * 33]); o.z = cvt_pk_bf16(s[4 * 33], s[5 * 33]); o.w = cvt_pk_bf16(s[6 * 33], s[7 * 33]);
        if (late) __builtin_nontemporal_store(o, (u32x4*)(WT + (size_t)(drow0 + n) * K + k0 + 8 * c)); else *(u32x4*)(WT + (size_t)(drow0 + n) * K + k0 + 8 * c) = o; }
    asm volatile("s_waitcnt lgkmcnt(0)" ::: "memory");
}
__device__ __forceinline__ int glu_row(int n0, int which) { return (n0 >> 7) * 256 + which * 128 + (n0 & 127); }
__device__ __forceinline__ int win_row(int n0) {
    if (n0 < SC) return n0;
    if (n0 < SC + DC) return 3584 + glu_row(n0 - SC, 0);
    return 3584 + glu_row(n0 - SC - DC, 1);
}
__device__ __forceinline__ void phase_prep(const Params& p, LAS unsigned char* lds, int G, int bid) {
    const int tid = threadIdx.x, lane = tid & 63, wid = tid >> 6;
    const int gw = bid * 8 + wid, NGW = G * 8;
    LAS float* scr = (LAS float*)(lds + wid * 8704);
    unsigned char* ws = p.ws;
    constexpr int I_FF = (D / 64) * (FF / 32);
    constexpr int I_IN = (D / 64) * (5408 / 32);
    constexpr int I_SQ = (D / 64) * (D / 32);
    constexpr int NITEMS = 6 * I_FF + I_IN + 5 * I_SQ;
    for (int it = gw; it < NITEMS; it += NGW) {
        int r = NITEMS - 1 - it;
        if (r < 6 * I_FF) {
            const int which = r / I_FF; r -= which * I_FF;
            const int layer = which / 3, kind = which % 3;
            if (kind < 2) {
                const float* W = p.in[layer ? (kind ? I_F2W3 : I_F2W1) : (kind ? I_F1W3 : I_F1W1)];
                bf16_t* WT = (bf16_t*)(ws + (layer ? WS_W13B : WS_W13A));
                const int nblk = FF / 32, kb = r / nblk, nb = r % nblk;
                transpose_item(W, D, FF, WT, kb * 64, nb * 32, glu_row(nb * 32, kind), scr, lane, layer != 0);
            } else {
                const float* W = p.in[layer ? I_F2W2 : I_F1W2];
                bf16_t* WT = (bf16_t*)(ws + (layer ? WS_W2B : WS_W2A));
                const int nblk = D / 32, kb = r / nblk, nb = r % nblk;
                transpose_item(W, FF, D, WT, kb * 64, nb * 32, nb * 32, scr, lane, layer != 0);
            }
            continue;
        }
        r -= 6 * I_FF;
        if (r < I_IN) {
            const int nblk = 5408 / 32, kb = r / nblk, nb = r % nblk;
            transpose_item(p.in[I_WIN], D, 5408, (bf16_t*)(ws + WS_WIN), kb * 64, nb * 32, win_row(nb * 32), scr, lane);
            continue;
        }
        r -= I_IN;
        {
            const int which = r / I_SQ; r -= which * I_SQ;
            const int idx = which == 0 ? I_WOUT : which == 1 ? I_WMQ : which == 2 ? I_WMK : which == 3 ? I_WMV : I_WMO;
            const size_t off = which == 0 ? WS_WOUT : which == 1 ? WS_WMQ : which == 2 ? WS_WMK : which == 3 ? WS_WMV : WS_WMO;
            const int nblk = D / 32, kb = r / nblk, nb = r % nblk;
            transpose_item(p.in[idx], D, D, (bf16_t*)(ws + off), kb * 64, nb * 32, nb * 32, scr, lane, which != 2 && which != 3);
        }
    }
    const int gt = bid * 512 + tid, NGT = G * 512;
    { u32x4* z = (u32x4*)(ws + WS_WIN + (size_t)SC * D * 2); const int n16 = (3584 - SC) * D * 2 / 16;
      for (int i = gt; i < n16; i += NGT) z[i] = (u32x4){0u, 0u, 0u, 0u}; }
    { bf16_t* WL = (bf16_t*)(ws + WS_WLORA);
      for (int i = gt; i < 3072 * LK; i += NGT) {
          const int n = i / LK, k = i % LK; float v = 0.f;
          if (n < 1024) { if (k < 64) v = p.in[I_W2D][(size_t)k * DR + n]; }
          else if (n < 2048) { if (k >= 64 && k < 128) v = p.in[I_A2][(size_t)(k - 64) * DR + (n - 1024)]; }
          else { if (k >= 128 && k < 288) v = p.in[I_G2][(size_t)(k - 128) * DR + (n - 2048)]; }
          WL[i] = f2bf(v);
      } }
    { u32x2* xb = (u32x2*)(ws + WS_XB); const f32x4* xp = (const f32x4*)p.in[I_XP]; const f32x4* xs = (const f32x4*)p.in[I_XS];
      constexpr int NP4 = MP * D / 4, NA4 = M * D / 4;
      for (int i = gt; i < NA4; i += NGT) { const f32x4 v = (i < NP4) ? xp[i] : xs[i - NP4]; xb[i] = (u32x2){cvt_pk_bf16(v[0], v[1]), cvt_pk_bf16(v[2], v[3])}; }
      u32x2* mb = (u32x2*)(ws + WS_MEMB); const f32x4* mp = (const f32x4*)p.in[I_MEM];
      for (int i = gt; i < 1024 * D / 4; i += NGT) { const f32x4 v = mp[i]; mb[i] = (u32x2){cvt_pk_bf16(v[0], v[1]), cvt_pk_bf16(v[2], v[3])}; } }
}

__device__ __forceinline__ void ln_finish(f32x4 (&v)[8], int row, int lane, const float* g, const float* b, float* outF, bf16_t* outB) {
    float s = 0.f;
#pragma unroll
    for (int j = 0; j < 8; ++j) s += (v[j][0] + v[j][1]) + (v[j][2] + v[j][3]);
    const float mean = wave_sum(s) * (1.f / D); float s2 = 0.f;
#pragma unroll
    for (int j = 0; j < 8; ++j) { v[j] = v[j] - mean; s2 += (v[j][0] * v[j][0] + v[j][1] * v[j][1]) + (v[j][2] * v[j][2] + v[j][3] * v[j][3]); }
    const float rstd = 1.f / sqrtf(wave_sum(s2) * (1.f / D) + LN_EPS);
#pragma unroll
    for (int j = 0; j < 8; ++j) {
        const f32x4 gv = ((const f32x4*)g)[64 * j + lane], bv = ((const f32x4*)b)[64 * j + lane];
        const f32x4 y = v[j] * rstd * gv + bv;
        if (outF) ((f32x4*)(outF + (size_t)row * D))[64 * j + lane] = y;
        if (outB) ((u32x2*)(outB + (size_t)row * D))[64 * j + lane] = (u32x2){cvt_pk_bf16(y[0], y[1]), cvt_pk_bf16(y[2], y[3])};
    }
}
__device__ __forceinline__ void phase_ln(LAS unsigned char* lds, const bf16_t* Z, const float* g, const float* b, float* outF, bf16_t* outB, int G, int bid, const float* PART, int nsl, const float* res1, const bf16_t* res1b, float scale) {
    const int tid = threadIdx.x, lane = tid & 63, wid = tid >> 6;
    const int gw = bid * 8 + wid, NGW = G * 8;
    {
        f32x4 cur[8], nxt[8];
        int row = gw;
        if (row < MP) {
#pragma unroll
            for (int j = 0; j < 8; ++j) { const u32x2 zb = ((const u32x2*)(Z + (size_t)row * D))[64 * j + lane]; cur[j][0] = __builtin_bit_cast(float, zb[0] << 16); cur[j][1] = __builtin_bit_cast(float, zb[0] & 0xffff0000u); cur[j][2] = __builtin_bit_cast(float, zb[1] << 16); cur[j][3] = __builtin_bit_cast(float, zb[1] & 0xffff0000u); }
        }
#pragma unroll 1
        while (row < MP) {
            const int nrow = row + NGW;
            if (nrow < MP) {
#pragma unroll
                for (int j = 0; j < 8; ++j) { const u32x2 zb = ((const u32x2*)(Z + (size_t)nrow * D))[64 * j + lane]; nxt[j][0] = __builtin_bit_cast(float, zb[0] << 16); nxt[j][1] = __builtin_bit_cast(float, zb[0] & 0xffff0000u); nxt[j][2] = __builtin_bit_cast(float, zb[1] << 16); nxt[j][3] = __builtin_bit_cast(float, zb[1] & 0xffff0000u); }
            }
            ln_finish(cur, row, lane, g, b, outF, outB);
#pragma unroll
            for (int j = 0; j < 8; ++j) cur[j] = nxt[j];
            row = nrow;
        }
    }
    if (bid < MS) {
        const int sr = bid;
        LAS float* red = (LAS float*)lds;
        f32x4 a = (f32x4){0.f, 0.f, 0.f, 0.f};
#pragma unroll
        for (int sl = 0; sl < 22; ++sl) if (sl < nsl) a += ((const f32x4*)(PART + ((size_t)sl * 128 + sr) * D))[64 * wid + lane];
        f32x4 rv;
        if (res1) rv = ((const f32x4*)(res1 + (size_t)sr * D))[64 * wid + lane];
        else { const u32x2 rb = ((const u32x2*)(res1b + (size_t)sr * D))[64 * wid + lane];
               rv[0] = __builtin_bit_cast(float, rb[0] << 16); rv[1] = __builtin_bit_cast(float, rb[0] & 0xffff0000u); rv[2] = __builtin_bit_cast(float, rb[1] << 16); rv[3] = __builtin_bit_cast(float, rb[1] & 0xffff0000u); }
        f32x4 v = rv * ALPHA + a * scale;
        const float ps = wave_sum((v[0] + v[1]) + (v[2] + v[3]));
        if (lane == 0) red[wid] = ps;
        __syncthreads();
        const float mean = (((red[0] + red[1]) + (red[2] + red[3])) + ((red[4] + red[5]) + (red[6] + red[7]))) * (1.f / D);
        v = v - mean;
        const float ps2 = wave_sum((v[0] * v[0] + v[1] * v[1]) + (v[2] * v[2] + v[3] * v[3]));
        if (lane == 0) red[8 + wid] = ps2;
        __syncthreads();
        const float rstd = 1.f / sqrtf((((red[8] + red[9]) + (red[10] + red[11])) + ((red[12] + red[13]) + (red[14] + red[15]))) * (1.f / D) + LN_EPS);
        const f32x4 gv = ((const f32x4*)g)[64 * wid + lane], bv = ((const f32x4*)b)[64 * wid + lane];
        const f32x4 y = v * rstd * gv + bv;
        if (outF) ((f32x4*)(outF + (size_t)(MP + sr) * D))[64 * wid + lane] = y;
        if (outB) ((u32x2*)(outB + (size_t)(MP + sr) * D))[64 * wid + lane] = (u32x2){cvt_pk_bf16(y[0], y[1]), cvt_pk_bf16(y[2], y[3])};
        __syncthreads();
    }
}

__device__ __forceinline__ void load_rkv_raw(const Params& p, int row, int ch, float (&c)[3], float (&q)[3]) {
    const float* PS = (const float*)(p.ws + WS_RA);
    const float* cur = PS + (size_t)row * SC;
    const float* prev;
    if (row < MP) { const int t = row & (SEQ - 1); prev = PS + (size_t)(row - (t ? 1 : 0)) * SC; }
    else prev = p.in[I_SSH] + (size_t)(row - MP) * SC;
    c[0] = cur[ch]; c[1] = cur[1024 + ch]; c[2] = cur[2048 + ch];
    q[0] = prev[ch]; q[1] = prev[1024 + ch]; q[2] = prev[2048 + ch];
}
__device__ __forceinline__ void load_rkv_cur(const Params& p, int row, int ch, float (&c)[3]) {
    const float* cur = (const float*)(p.ws + WS_RA) + (size_t)row * SC;
    c[0] = cur[ch]; c[1] = cur[1024 + ch]; c[2] = cur[2048 + ch];
}
__device__ __forceinline__ void load_rkv_prev(const Params& p, int row, int ch, float (&q)[3]) {
    const int t = row & (SEQ - 1);
    const float* prev = (const float*)(p.ws + WS_RA) + (size_t)(row - (t ? 1 : 0)) * SC;
    q[0] = prev[ch]; q[1] = prev[1024 + ch]; q[2] = prev[2048 + ch];
}
__device__ __forceinline__ float shift_mix(float c, float q, float mu, bool zprev) { const float pq = zprev ? 0.f : q; return c + mu * (pq - c); }
__device__ __forceinline__ void phase_mixpre(const Params& p, int G, int bid) {
    const int tid = threadIdx.x, lane = tid & 63, wid = tid >> 6;
    const int gw = bid * 8 + wid, NGW = G * 8;
    unsigned char* ws = p.ws;
    const float* PS = (const float*)(ws + WS_RA); bf16_t* LA = (bf16_t*)(ws + WS_LA);
    const float* mu = p.in[I_MU];
    for (int row = gw; row < M; row += NGW) {
        const f32x4* cur = (const f32x4*)(PS + (size_t)row * SC);
        const f32x4* prev; bool zprev = false; float* shout = nullptr;
        if (row < MP) { const int t = row & (SEQ - 1); zprev = (t == 0); prev = (const f32x4*)(PS + (size_t)(row - (zprev ? 0 : 1)) * SC);
                        if (t == SEQ - 1) shout = p.out + O_SHP + (size_t)(row >> 11) * SC; }
        else { prev = (const f32x4*)(p.in[I_SSH] + (size_t)(row - MP) * SC); shout = p.out + O_SHS + (size_t)(row - MP) * SC; }
        if (shout) for (int i = lane; i < SC / 4; i += 64) ((f32x4*)shout)[i] = cur[i];
        for (int i = 768 + lane; i < SC / 4; i += 64) {
            const f32x4 c = cur[i]; f32x4 pv = prev[i]; if (zprev) pv = (f32x4){0.f, 0.f, 0.f, 0.f};
            const f32x4 m4 = ((const f32x4*)mu)[i];
            const f32x4 pm = c + m4 * (pv - c);
            const int col = 4 * i;
            f32x4 a;
            if (col < 3136) { for (int j = 0; j < 4; ++j) a[j] = tanhf(pm[j]); }
            else if (col < 3200) a = pm;
            else { for (int j = 0; j < 4; ++j) a[j] = 1.f / (1.f + expf(-pm[j])); }
            *(u32x2*)(LA + (size_t)row * LK + (col - 3072)) = (u32x2){cvt_pk_bf16(a[0], a[1]), cvt_pk_bf16(a[2], a[3])};
        }
        if (lane < 24) *(u32x2*)(LA + (size_t)row * LK + 288 + 4 * lane) = (u32x2){0u, 0u};
    }
    const int gt = bid * 512 + tid, NGT = G * 512;
    const f32x4* U4 = (const f32x4*)(ws + WS_U);
    { f32x4* o = (f32x4*)(p.out + O_CVP);
      for (int i = gt; i < NB * 30 * DC / 4; i += NGT) { const int c4 = i & 255, j = (i >> 8) % 30, b = (i >> 8) / 30; o[i] = U4[(size_t)(b * SEQ + SEQ - 30 + j) * 256 + c4]; } }
    { f32x4* o = (f32x4*)(p.out + O_CVS); const f32x4* sc = (const f32x4*)p.in[I_SCV];
      for (int i = gt; i < MS * 30 * DC / 4; i += NGT) { const int c4 = i & 255, j = (i >> 8) % 30, s = (i >> 8) / 30;
          o[i] = (j < 29) ? sc[(size_t)(s * 30 + j + 1) * 256 + c4] : U4[(size_t)(MP + s) * 256 + c4]; } }
}

constexpr int TC = 32;
__device__ __forceinline__ void rwkv_sample8(const Params& p, LAS unsigned char* lds, int j0) {
    LAS float* sR = (LAS float*)lds; LAS float* sK = sR + 8 * 64; LAS float* sV = sK + 8 * 64; LAS float* sW = sV + 8 * 64;
    LAS float* sKK = sW + 8 * 64; LAS float* sB = sKK + 8 * 64; LAS float* sY = sB + 8 * 64;
    const int tid = threadIdx.x, lane = tid & 63, wid = tid >> 6;
    const int v = wid * 8 + (lane >> 3), kq = lane & 7;
    const float* DAG = (const float*)(p.ws + WS_RB); bf16_t* OMIX = (bf16_t*)(p.ws + WS_OMIX);
    const int jw = j0 + wid, sw = jw >> 4, hw = jw & 15, roww = MP + sw, ch = hw * 64 + lane;
    const float rk_w = p.in[I_RK][ch], gng = p.in[I_GNG][ch], gnb = p.in[I_GNB][ch], beta = p.in[I_BR][ch];
    {
        const float mu_r = p.in[I_MU][ch], mu_k = p.in[I_MU][1024 + ch], mu_v = p.in[I_MU][2048 + ch], kk_w = p.in[I_KK][ch], ka_w = p.in[I_KA][ch];
        const float* dag = DAG + (size_t)roww * 3072;
        float cc[3], qq[3]; load_rkv_raw(p, roww, ch, cc, qq);
        const float r = shift_mix(cc[0], qq[0], mu_r, false), k = shift_mix(cc[1], qq[1], mu_k, false), vv = shift_mix(cc[2], qq[2], mu_v, false), w = dag[ch], a = dag[1024 + ch];
        const float kr = k * kk_w; const float n2 = wave_sum(kr * kr); const float kk = kr / fmaxf(sqrtf(n2), 1e-12f);
        const float kp = k * (1.f + (a - 1.f) * ka_w);
        const int o = wid * 64 + lane;
        sR[o] = r; sK[o] = kp; sV[o] = vv; sW[o] = w; sKK[o] = kk; sB[o] = kk * a;
    }
    f32x4 Sa[8], Sb[8];
#pragma unroll
    for (int q = 0; q < 8; ++q) { const float* st = p.in[I_SWKV] + (size_t)(j0 + q) * HD * HD + v * 64 + kq * 8; Sa[q] = *(const f32x4*)st; Sb[q] = *(const f32x4*)(st + 4); }
    __syncthreads();
#pragma unroll
    for (int q = 0; q < 8; ++q) {
        const int o = q * 64 + kq * 8;
        const f32x4 w0 = *(const LAS f32x4*)(sW + o), w1 = *(const LAS f32x4*)(sW + o + 4);
        const f32x4 q0 = *(const LAS f32x4*)(sKK + o), q1 = *(const LAS f32x4*)(sKK + o + 4);
        const f32x4 b0 = *(const LAS f32x4*)(sB + o), b1 = *(const LAS f32x4*)(sB + o + 4);
        const f32x4 k0 = *(const LAS f32x4*)(sK + o), k1 = *(const LAS f32x4*)(sK + o + 4);
        const f32x4 r0 = *(const LAS f32x4*)(sR + o), r1 = *(const LAS f32x4*)(sR + o + 4);
        const float vv = sV[q * 64 + v];
        f32x4 A = Sa[q], B = Sb[q];
        float sa = 0.f;
#pragma unroll
        for (int j = 0; j < 4; ++j) { sa += A[j] * q0[j]; sa += B[j] * q1[j]; }
        sa = -red8(sa);
        float y = 0.f;
#pragma unroll
        for (int j = 0; j < 4; ++j) {
            A[j] = A[j] * w0[j] + sa * b0[j] + vv * k0[j];
            B[j] = B[j] * w1[j] + sa * b1[j] + vv * k1[j];
            y += A[j] * r0[j]; y += B[j] * r1[j];
        }
        y = red8(y);
        if (kq == 0) sY[q * 64 + v] = y;
        float* so = p.out + O_WKS + (size_t)(j0 + q) * HD * HD + v * 64 + kq * 8;
        *(f32x4*)so = A; *(f32x4*)(so + 4) = B;
    }
    __syncthreads();
    {
        const int o = wid * 64 + lane;
        const float y = sY[o];
        const float mu = wave_sum(y) * (1.f / 64.f); const float d = y - mu; const float var = wave_sum(d * d) * (1.f / 64.f);
        const float yn = d * (1.f / sqrtf(var + GN_EPS)) * gng + gnb;
        const float bonus = wave_sum(sR[o] * sK[o] * rk_w) * sV[o];
        const float g = DAG[(size_t)roww * 3072 + 2048 + ch];
        OMIX[(size_t)roww * D + ch] = f2bf((yn + bonus) * g * beta);
    }
    __syncthreads();
}

__device__ __forceinline__ void conv_item(const Params& p, LAS unsigned char* lds, int it) {
    const int tid = threadIdx.x, lane = tid & 63, wid = tid >> 6;
    const int c = 2 * tid;
    const float* U = (const float*)(p.ws + WS_U); bf16_t* OMIX = (bf16_t*)(p.ws + WS_OMIX);
    const bool samp = it >= 1024;
    const int b = it >> 8, t0 = (it & 255) * 8, s = it - 1024;
    const int row0 = samp ? MP + s : b * SEQ + t0;
    const int ntok = samp ? 1 : 8;
    f32x2 w[CW];
#pragma unroll
    for (int j = 0; j < CW; ++j) w[j] = *(const f32x2*)(p.in[I_CVW] + (size_t)j * DC + c);
    const f32x2 bias = *(const f32x2*)(p.in[I_CVB] + c);
    f32x2 acc[8];
#pragma unroll
    for (int i = 0; i < 8; ++i) acc[i] = bias;
#pragma unroll
    for (int q = 0; q < 38; ++q) {
        f32x2 u = (f32x2){0.f, 0.f};
        if (samp) { if (q < 30) u = *(const f32x2*)(p.in[I_SCV] + (size_t)(s * 30 + q) * DC + c); else if (q == 30) u = *(const f32x2*)(U + (size_t)(MP + s) * DC + c); }
        else { const int t = t0 - 30 + q; if (t >= 0) u = *(const f32x2*)(U + (size_t)(b * SEQ + t) * DC + c); }
#pragma unroll
        for (int i = 0; i < 8; ++i) { const int j = q - i; if (j >= 0 && j < CW) acc[i] += w[j] * u; }
    }
    LAS float* sC = (LAS float*)lds;
#pragma unroll
    for (int i = 0; i < 8; ++i) *(LAS f32x2*)(sC + i * DC + c) = acc[i];
    __syncthreads();
    if (wid < ntok) {
        const LAS f32x4* cr = (const LAS f32x4*)(sC + wid * DC) + lane;
        f32x4 v[4]; float sm = 0.f;
#pragma unroll
        for (int j = 0; j < 4; ++j) { v[j] = cr[64 * j]; sm += (v[j][0] + v[j][1]) + (v[j][2] + v[j][3]); }
        const float mean = wave_sum(sm) * (1.f / DC); float s2 = 0.f;
#pragma unroll
        for (int j = 0; j < 4; ++j) { v[j] = v[j] - mean; s2 += (v[j][0] * v[j][0] + v[j][1] * v[j][1]) + (v[j][2] * v[j][2] + v[j][3] * v[j][3]); }
        const float rstd = 1.f / sqrtf(wave_sum(s2) * (1.f / DC) + LN_EPS);
        bf16_t* orow = OMIX + (size_t)(row0 + wid) * D + DR;
#pragma unroll
        for (int j = 0; j < 4; ++j) {
            const f32x4 gv = ((const f32x4*)p.in[I_CLG])[64 * j + lane], bv = ((const f32x4*)p.in[I_CLB])[64 * j + lane], be = ((const f32x4*)p.in[I_BC])[64 * j + lane];
            f32x4 y = v[j] * rstd * gv + bv;
#pragma unroll
            for (int e = 0; e < 4; ++e) y[e] = y[e] / (1.f + expf(-y[e])) * be[e];
            ((u32x2*)orow)[64 * j + lane] = (u32x2){cvt_pk_bf16(y[0], y[1]), cvt_pk_bf16(y[2], y[3])};
        }
    }
    __syncthreads();
}
constexpr int SBUF = 6 * TC * 64;
struct ProdRegs { float c[8][3], q0[3], w[8], a[8]; };
__device__ __forceinline__ void prod_load(const Params& p, ProdRegs& R, int row0, int h, int pw, int lane) {
    const float* DAG = (const float*)(p.ws + WS_RB);
    const int ch = h * 64 + lane;
#pragma unroll
    for (int i = 0; i < 8; ++i) {
        const int s = pw * 8 + i;
        const float* dag = DAG + (size_t)(row0 + s) * 3072;
        load_rkv_cur(p, row0 + s, ch, R.c[i]);
        R.w[i] = dag[ch]; R.a[i] = dag[1024 + ch];
    }
    load_rkv_prev(p, row0 + pw * 8, ch, R.q0);
}
__device__ __forceinline__ void prod_store(const ProdRegs& R, LAS float* buf, int row0, int pw, int lane, float kk_w, float ka_w, float mu_r, float mu_k, float mu_v) {
#pragma unroll
    for (int i = 0; i < 8; ++i) {
        const int s = pw * 8 + i;
        const bool zp = (i == 0) && (((row0 + s) & (SEQ - 1)) == 0);
        const float qr = i ? R.c[i ? i - 1 : 0][0] : R.q0[0], qk = i ? R.c[i ? i - 1 : 0][1] : R.q0[1], qv = i ? R.c[i ? i - 1 : 0][2] : R.q0[2];
        const float r = shift_mix(R.c[i][0], qr, mu_r, zp), k = shift_mix(R.c[i][1], qk, mu_k, zp), vv = shift_mix(R.c[i][2], qv, mu_v, zp);
        const float kr = k * kk_w; const float n2 = wave_sum(kr * kr); const float kk = kr * __builtin_amdgcn_rsqf(fmaxf(n2, 1e-24f));
        const float kp = k * (1.f + (R.a[i] - 1.f) * ka_w);
        const int o = s * 64 + lane;
        buf[o] = r; buf[TC * 64 + o] = kp; buf[2 * TC * 64 + o] = vv; buf[3 * TC * 64 + o] = R.w[i]; buf[4 * TC * 64 + o] = kk; buf[5 * TC * 64 + o] = kk * R.a[i];
    }
}
struct StepRegs { f32x4 r4, k4, w4, q4, b4; float vv; };
__device__ __forceinline__ void step_load(StepRegs& T, const LAS float* pb, const LAS float* pv, int s) {
    T.r4 = *(const LAS f32x4*)(pb + s * 64); T.k4 = *(const LAS f32x4*)(pb + TC * 64 + s * 64); T.w4 = *(const LAS f32x4*)(pb + 3 * TC * 64 + s * 64);
    T.q4 = *(const LAS f32x4*)(pb + 4 * TC * 64 + s * 64); T.b4 = *(const LAS f32x4*)(pb + 5 * TC * 64 + s * 64); T.vv = pv[s * 64];
}
__device__ __forceinline__ f32x2 lo2(const f32x4& a) { return __builtin_shufflevector(a, a, 0, 1); }
__device__ __forceinline__ f32x2 hi2(const f32x4& a) { return __builtin_shufflevector(a, a, 2, 3); }
__device__ __forceinline__ void red16x2(float& a, float& b) {
    a += dppf<0xB1>(a); b += dppf<0xB1>(b); a += dppf<0x4E>(a); b += dppf<0x4E>(b);
    a += dppf<0x141>(a); b += dppf<0x141>(b); a += dppf<0x140>(a); b += dppf<0x140>(b);
}
template <bool STORE>
__device__ __forceinline__ void step_compute(const StepRegs& T, const f32x4& rprev, f32x2& S01, f32x2& S23, float* yprev) {
    const f32x2 vv2 = (f32x2){T.vv, T.vv};
    const f32x2 t01 = S01 * lo2(T.w4) + vv2 * lo2(T.k4), t23 = S23 * hi2(T.w4) + vv2 * hi2(T.k4);
    const f32x2 dv = S23 * hi2(T.q4) + S01 * lo2(T.q4);
    const f32x2 ev = S23 * hi2(rprev) + S01 * lo2(rprev);
    float d = dv[0] + dv[1], e = ev[0] + ev[1];
    red16x2(d, e);
    if (STORE) *yprev = e;
    const f32x2 d2 = (f32x2){d, d};
    S01 = t01 - d2 * lo2(T.b4); S23 = t23 - d2 * hi2(T.b4);
}
__device__ __forceinline__ void scan_consume(const LAS float* buf, f32x2& S01, f32x2& S23, int v, int kq, float* Yp) {
    const LAS float* pb = buf + kq * 4; const LAS float* pv = buf + 2 * TC * 64 + v;
    StepRegs A, B;
    step_load(A, pb, pv, 0);
    step_load(B, pb, pv, 1);
    step_compute<false>(A, A.r4, S01, S23, Yp);
#pragma unroll
    for (int s = 1; s < TC; s += 2) {
        const f32x4 rA = A.r4;
        if (s + 1 < TC) step_load(A, pb, pv, s + 1);
        step_compute<true>(B, rA, S01, S23, Yp + (size_t)(s - 1) * 1024);
        if (s + 1 < TC) {
            const f32x4 rB = B.r4;
            if (s + 2 < TC) step_load(B, pb, pv, s + 2);
            step_compute<true>(A, rB, S01, S23, Yp + (size_t)s * 1024);
        }
    }
    { const f32x2 ev = S23 * hi2(B.r4) + S01 * lo2(B.r4); Yp[(size_t)(TC - 1) * 1024] = red16(ev[0] + ev[1]); }
}
__device__ __forceinline__ void phase_scan(const Params& p, LAS unsigned char* lds, int G, int bid) {
    const int tid = threadIdx.x, lane = tid & 63, wid = __builtin_amdgcn_readfirstlane(tid >> 6);
    LAS float* buf0 = (LAS float*)lds; LAS float* buf1 = buf0 + SBUF;
    float* Y = (float*)(p.ws + WS_Y);
    constexpr int NCH = SEQ / TC;
    for (int item = bid; item < NB * NH * 4; item += G) {
        const int bh = item >> 2, qd = item & 3, b = bh >> 4, h = bh & 15, row0 = b * SEQ;
        const int ch = h * 64 + lane;
        const float kk_w = p.in[I_KK][ch], ka_w = p.in[I_KA][ch], mu_r = p.in[I_MU][ch], mu_k = p.in[I_MU][1024 + ch], mu_v = p.in[I_MU][2048 + ch];
        f32x2 S01 = (f32x2){0.f, 0.f}, S23 = (f32x2){0.f, 0.f};
        const int v = qd * 16 + (wid & 3) * 4 + (lane >> 4), kq = lane & 15;
        ProdRegs R;
        if (wid >= 4) { prod_load(p, R, row0, h, wid - 4, lane); prod_store(R, buf0, row0, wid - 4, lane, kk_w, ka_w, mu_r, mu_k, mu_v); prod_load(p, R, row0 + TC, h, wid - 4, lane); }
        asm volatile("s_waitcnt lgkmcnt(0)" ::: "memory"); __builtin_amdgcn_s_barrier(); asm volatile("" ::: "memory");
#pragma unroll 1
        for (int c = 0; c < NCH; ++c) {
            LAS float* cb = (c & 1) ? buf1 : buf0; LAS float* nb = (c & 1) ? buf0 : buf1;
            if (wid < 4) scan_consume(cb, S01, S23, v, kq, Y + (size_t)(row0 + c * TC) * 1024 + h * 64 + v);
            else {
                if (c + 1 < NCH) prod_store(R, nb, row0 + (c + 1) * TC, wid - 4, lane, kk_w, ka_w, mu_r, mu_k, mu_v);
                if (c + 2 < NCH) prod_load(p, R, row0 + (c + 2) * TC, h, wid - 4, lane);
            }
            asm volatile("s_waitcnt lgkmcnt(0)" ::: "memory"); __builtin_amdgcn_s_barrier(); asm volatile("" ::: "memory");
        }
        if (wid < 4) *(f32x4*)(p.out + O_WKP + (size_t)bh * HD * HD + v * 64 + kq * 4) = (f32x4){S01[0], S01[1], S23[0], S23[1]};
    }
}
__device__ __forceinline__ void phase_mix2(const Params& p, LAS unsigned char* lds, int G, int bid) {
    const int tid = threadIdx.x, lane = tid & 63, wid = tid >> 6;
    {
        const float* DAG = (const float*)(p.ws + WS_RB); const float* Y = (const float*)(p.ws + WS_Y); bf16_t* OMIX = (bf16_t*)(p.ws + WS_OMIX);
        const int gw = bid * 8 + wid, NGW = G * 8;
        const int h = gw & 15, ch = h * 64 + lane;
        const float ka_w = p.in[I_KA][ch], rk_w = p.in[I_RK][ch], gng = p.in[I_GNG][ch], gnb = p.in[I_GNB][ch], beta = p.in[I_BR][ch];
        const float mu_r = p.in[I_MU][ch], mu_k = p.in[I_MU][1024 + ch], mu_v = p.in[I_MU][2048 + ch];
        const int rstep = NGW >> 4;
        for (int grp = gw >> 4; grp < MP / 4; grp += rstep) {
            const int rb = grp * 4;
            float y[4], cc[4][3], q0[3], a[4], g[4];
#pragma unroll
            for (int u = 0; u < 4; ++u) {
                const int row = rb + u; const float* dag = DAG + (size_t)row * 3072;
                load_rkv_cur(p, row, ch, cc[u]); y[u] = Y[(size_t)row * 1024 + ch]; a[u] = dag[1024 + ch]; g[u] = dag[2048 + ch];
            }
            load_rkv_prev(p, rb, ch, q0);
#pragma unroll
            for (int u = 0; u < 4; ++u) {
                const int row = rb + u;
                const bool zp = (u == 0) && ((row & (SEQ - 1)) == 0);
                const float qr = u ? cc[u ? u - 1 : 0][0] : q0[0], qk = u ? cc[u ? u - 1 : 0][1] : q0[1], qv = u ? cc[u ? u - 1 : 0][2] : q0[2];
                const float r = shift_mix(cc[u][0], qr, mu_r, zp), k = shift_mix(cc[u][1], qk, mu_k, zp), vv = shift_mix(cc[u][2], qv, mu_v, zp);
                const float kp = k * (1.f + (a[u] - 1.f) * ka_w);
                const float mu = wave_sum(y[u]) * (1.f / 64.f); const float d = y[u] - mu; const float var = wave_sum(d * d) * (1.f / 64.f);
                const float yn = d * (1.f / sqrtf(var + GN_EPS)) * gng + gnb;
                const float bonus = wave_sum(r * kp * rk_w) * vv;
                OMIX[(size_t)row * D + ch] = f2bf((yn + bonus) * g[u] * beta);
            }
        }
    }
    constexpr int NCONV = 1024 + MS, NSAMP8 = MS * NH / 8;
    for (int it = bid; it < NCONV + NSAMP8; it += G) {
        if (it < NCONV) conv_item(p, lds, it);
        else rwkv_sample8(p, lds, (it - NCONV) * 8);
    }
}

__device__ __forceinline__ void samp_attn_item(const Params& p, LAS unsigned char* lds, int it) {
    const int tid = threadIdx.x, lane = tid & 63, wid = tid >> 6;
    const int s = it >> 2, h = it & 3;
    bf16_t* OA = (bf16_t*)(p.ws + WS_OA) + (size_t)(MP + s) * D + h * MHD;
    LAS float* sS = (LAS float*)lds;
    LAS float* sO = sS + 256;
    float q[8];
    { const float* PART = (const float*)(p.ws + WS_PART) + (size_t)s * D + h * MHD;
      f32x4 a = (f32x4){0.f, 0.f, 0.f, 0.f}, b = a;
#pragma unroll
      for (int sl = 0; sl < 8; ++sl) { a += *(const f32x4*)(PART + (size_t)sl * 128 * D + lane * 4); b += *(const f32x4*)(PART + (size_t)sl * 128 * D + 256 + lane * 4); }
#pragma unroll
      for (int j = 0; j < 4; ++j) { q[j] = a[j] * QSCALE; q[4 + j] = b[j] * QSCALE; } }
    const float* Kc = p.in[I_CK] + ((size_t)s * NMEM * NMH + h) * MHD;
    const float* Vc = p.in[I_CV] + ((size_t)s * NMEM * NMH + h) * MHD;
#pragma unroll 1
    for (int kb = 0; kb < 32; kb += 4) {
        f32x4 ka[4], kb4[4];
#pragma unroll
        for (int u = 0; u < 4; ++u) { const float* kr = Kc + (size_t)(wid * 32 + kb + u) * D; ka[u] = __builtin_nontemporal_load((const f32x4*)(kr + lane * 4)); kb4[u] = __builtin_nontemporal_load((const f32x4*)(kr + 256 + lane * 4)); }
#pragma unroll
        for (int u = 0; u < 4; ++u) {
            float d = ka[u][0] * q[0] + ka[u][1] * q[1] + ka[u][2] * q[2] + ka[u][3] * q[3] + kb4[u][0] * q[4] + kb4[u][1] * q[5] + kb4[u][2] * q[6] + kb4[u][3] * q[7];
            d = wave_sum(d);
            if (lane == 0) sS[wid * 32 + kb + u] = d;
        }
    }
    __syncthreads();
    {
        const float s0 = sS[lane], s1 = sS[lane + 64], s2 = sS[lane + 128], s3 = sS[lane + 192];
        const float mx = wave_max(fmaxf(fmaxf(s0, s1), fmaxf(s2, s3)));
        const float e0 = __expf(s0 - mx), e1 = __expf(s1 - mx), e2 = __expf(s2 - mx), e3 = __expf(s3 - mx);
        const float inv = 1.f / wave_sum((e0 + e1) + (e2 + e3));
        __syncthreads();
        if (wid == 0) { sS[lane] = e0 * inv; sS[lane + 64] = e1 * inv; sS[lane + 128] = e2 * inv; sS[lane + 192] = e3 * inv; }
    }
    __syncthreads();
    {
        const int g = tid >> 7, d4 = tid & 127;
        f32x4 o = (f32x4){0.f, 0.f, 0.f, 0.f};
#pragma unroll 1
        for (int kb = 0; kb < 64; kb += 8) {
            f32x4 vv[8];
#pragma unroll
            for (int u = 0; u < 8; ++u) vv[u] = __builtin_nontemporal_load((const f32x4*)(Vc + (size_t)(g * 64 + kb + u) * D + d4 * 4));
#pragma unroll
            for (int u = 0; u < 8; ++u) o += vv[u] * sS[g * 64 + kb + u];
        }
        *(LAS f32x4*)(sO + g * 512 + d4 * 4) = o;
    }
    __syncthreads();
    if (tid < 128) {
        const f32x4 o = (*(const LAS f32x4*)(sO + tid * 4) + *(const LAS f32x4*)(sO + 512 + tid * 4)) + (*(const LAS f32x4*)(sO + 1024 + tid * 4) + *(const LAS f32x4*)(sO + 1536 + tid * 4));
        *(u32x2*)(OA + tid * 4) = (u32x2){cvt_pk_bf16(o[0], o[1]), cvt_pk_bf16(o[2], o[3])};
    }
    __syncthreads();
}

#define XB_TMO      128
#define XB_XCNT(j)  (256  + 64 * (j))
#define XB_XSUB(j)  (1280 + 64 * (j))
#define XB_XGEN(j)  (2304 + 64 * (j))
#define XB_TOP      3328
#define XB_TOPGEN   3392
#define XCD_BAR_WORDS 3456
#define XB_SPIN_CAP (1u << 18)
__device__ __forceinline__ unsigned xb_ld(unsigned* p)              { return __hip_atomic_load(p, __ATOMIC_RELAXED, __HIP_MEMORY_SCOPE_AGENT); }
__device__ __forceinline__ unsigned xb_add(unsigned* p, unsigned v) { return __hip_atomic_fetch_add(p, v, __ATOMIC_RELAXED, __HIP_MEMORY_SCOPE_AGENT); }
__device__ __forceinline__ unsigned xb_xcc_id() { return (unsigned)__builtin_amdgcn_s_getreg((3 << 11) | 20) & 0xFu; }
#define XB_SPIN(cond, bar) do { unsigned _sp = 0; while (cond) { __builtin_amdgcn_s_sleep(1); \
    if ((++_sp & 255u) == 0u) { if (xb_ld(&(bar)[XB_TMO])) break; if (_sp > XB_SPIN_CAP) { atomicAdd(&(bar)[XB_TMO], 1u); break; } } } } while (0)
struct XcdBarrier { unsigned* bar; unsigned x; volatile LAS unsigned* st; };
__device__ __forceinline__ XcdBarrier xcd_barrier_post(unsigned* bar, volatile LAS unsigned* st) {
    XcdBarrier b; b.bar = bar; b.x = xb_xcc_id(); b.st = st;
    if (threadIdx.x == 0) (void)xb_add(&bar[XB_XCNT(b.x)], 1u);
    return b;
}
__device__ __forceinline__ void xcd_barrier_complete(unsigned* bar, unsigned x, unsigned& nloc, unsigned& nx) {
    const unsigned G = gridDim.x * gridDim.y * gridDim.z;
    unsigned sum, cnt, mine, sp = 0u;
    for (;;) {
        sum = 0u; cnt = 0u; mine = 0u;
#pragma unroll
        for (unsigned j = 0; j < 16; ++j) { const unsigned c = xb_ld(&bar[XB_XCNT(j)]); sum += c; cnt += (c > 0u) ? 1u : 0u; mine = (j == x) ? c : mine; }
        if (sum == G) break;
        __builtin_amdgcn_s_sleep(1);
        if ((++sp & 255u) == 0u) { if (xb_ld(&bar[XB_TMO])) break; if (sp > XB_SPIN_CAP) { atomicAdd(&bar[XB_TMO], 1u); break; } }
    }
    nloc = mine > 0u ? mine : 1u; nx = cnt > 0u ? cnt : 1u;
}
__device__ __forceinline__ void xcd_barrier(const XcdBarrier& b) {
    asm volatile("s_waitcnt vmcnt(0)" ::: "memory");
    __syncthreads();
    if (threadIdx.x == 0) {
        unsigned* bar = b.bar;
        __builtin_amdgcn_s_waitcnt(0);
        unsigned nloc = b.st[0], nx = b.st[1];
        if (nloc == 0u) { xcd_barrier_complete(bar, b.x, nloc, nx); b.st[0] = nloc; b.st[1] = nx; }
        const unsigned old = xb_add(&bar[XB_XSUB(b.x)], 1u);
        const unsigned gen = old / nloc;
        if (old + 1u == (gen + 1u) * nloc) {
            __builtin_amdgcn_fence(__ATOMIC_RELEASE, "agent");
            asm volatile("s_waitcnt vmcnt(0)" ::: "memory");
            const unsigned og = xb_add(&bar[XB_TOP], 1u);
            const unsigned tg = og / nx;
            if (og + 1u == (tg + 1u) * nx) xb_add(&bar[XB_TOPGEN], 1u);
            else XB_SPIN(xb_ld(&bar[XB_TOPGEN]) == tg, bar);
            __builtin_amdgcn_fence(__ATOMIC_ACQUIRE, "agent");
            xb_add(&bar[XB_XGEN(b.x)], 1u);
            asm volatile("s_waitcnt vmcnt(0)" ::: "memory");
        } else {
            XB_SPIN(xb_ld(&bar[XB_XGEN(b.x)]) == gen, bar);
            __builtin_amdgcn_fence(__ATOMIC_ACQUIRE, "agent");
            asm volatile("s_waitcnt vmcnt(0)" ::: "memory");
        }
    }
    __syncthreads();
}

__global__ void __launch_bounds__(512, 2) fwd_megakernel(Params p) {
    extern __shared__ __attribute__((aligned(16))) unsigned char lds_raw[];
    LAS unsigned char* lds = (LAS unsigned char*)lds_raw;
    cg::grid_group grid = cg::this_grid();
    const int G = gridDim.x, bid = blockIdx.x;
    unsigned char* ws = p.ws;
    const int lo = p.ph_lo, hi = p.ph_hi;
#define IN(k) (lo <= (k) && (k) < hi)
    volatile LAS unsigned* bst = (volatile LAS unsigned*)(lds + 131072);
    if (threadIdx.x < 2) bst[threadIdx.x] = 0u;
    __syncthreads();
    XcdBarrier xbar = xcd_barrier_post((unsigned*)(ws + WS_CTL), bst);
    if (p.ph_hi < 0) grid.sync();
#define SEAM(k) do { if (IN(k) && IN((k) + 1)) xcd_barrier(xbar); } while (0)
#define EXTRA_SYNC() xcd_barrier(xbar)
    bf16_t* XB = (bf16_t*)(ws + WS_XB); bf16_t* Z = (bf16_t*)(ws + WS_Z); float* XF = (float*)(ws + WS_XF);
    bf16_t* Hb = (bf16_t*)(ws + WS_RB);

    float* PART = (float*)(ws + WS_PART);
    if (IN(0)) { for (int _r = 0; _r <= ((DUPMASK >> 0) & 1); ++_r) { phase_prep(p, lds, G, bid);  if (_r < ((DUPMASK >> 0) & 1)) EXTRA_SYNC(); } } SEAM(0);
    if (IN(1)) { for (int _r = 0; _r <= ((DUPMASK >> 1) & 1); ++_r) {
        { SchedPlain S; S.init(XB, ws + WS_W13A, D, D, 33, 44, G, bid); EpiGluH E{Hb}; gemm_phase(lds, D, D, D, S, E); }
        { SchedPlain S; S.init(ws + WS_MEMB, ws + WS_WMK, D, D, 4, 16, G, G - 1 - bid); EpiMemKV E{p.out + O_MKP, p.out + O_MVP, (bf16_t*)(ws + WS_KB), (bf16_t*)(ws + WS_VT)}; gemm_phase(lds, D, D, D, S, E); }
     if (_r < ((DUPMASK >> 1) & 1)) EXTRA_SYNC(); } } SEAM(1);
    if (IN(2)) { for (int _r = 0; _r <= ((DUPMASK >> 2) & 1); ++_r) {
        { SchedPlain S; S.init(Hb, ws + WS_W2A, FF, FF, 32, 8, G, bid); EpiResidB E{Z, XB, 0.5f}; gemm_phase(lds, FF, FF, FF, S, E); }
        { SchedPieces S{(const char*)Hb, (const char*)(ws + WS_W2A), FF, FF, 8 * 22, G, bid}; EpiPart E{PART}; gemm_phase(lds, FF, FF, 256, S, E); }
     if (_r < ((DUPMASK >> 2) & 1)) EXTRA_SYNC(); } } SEAM(2);
    if (IN(3)) { for (int _r = 0; _r <= ((DUPMASK >> 3) & 1); ++_r) { phase_ln(lds, Z, p.in[I_LN1G], p.in[I_LN1B], nullptr, XB, G, bid, PART, 22, p.in[I_XS], nullptr, 0.5f);  if (_r < ((DUPMASK >> 3) & 1)) EXTRA_SYNC(); } } SEAM(3);
    if (IN(4)) { for (int _r = 0; _r <= ((DUPMASK >> 4) & 1); ++_r) {
        SchedPlain S; S.init(XB, ws + WS_WIN, D, D, 33, 22, G, bid); EpiWin E{(float*)(ws + WS_RA), (float*)(ws + WS_U)}; gemm_phase(lds, D, D, D, S, E);
     if (_r < ((DUPMASK >> 4) & 1)) EXTRA_SYNC(); } } SEAM(4);
    if (IN(5)) { for (int _r = 0; _r <= ((DUPMASK >> 5) & 1); ++_r) { phase_mixpre(p, G, bid);  if (_r < ((DUPMASK >> 5) & 1)) EXTRA_SYNC(); } } SEAM(5);
    if (IN(6)) { for (int _r = 0; _r <= ((DUPMASK >> 6) & 1); ++_r) {
        SchedPlain S; S.init(ws + WS_LA, ws + WS_WLORA, LK, LK, 33, 12, G, bid); EpiLora E{(float*)(ws + WS_RB), p.in[I_W0], p.in[I_A0]}; gemm_phase(lds, LK, LK, LK, S, E);
     if (_r < ((DUPMASK >> 6) & 1)) EXTRA_SYNC(); } } SEAM(6);
    if (IN(7)) { for (int _r = 0; _r <= ((DUPMASK >> 7) & 1); ++_r) { phase_scan(p, lds, G, bid);  if (_r < ((DUPMASK >> 7) & 1)) EXTRA_SYNC(); } } SEAM(7);
    if (IN(8)) { for (int _r = 0; _r <= ((DUPMASK >> 8) & 1); ++_r) { phase_mix2(p, lds, G, bid);  if (_r < ((DUPMASK >> 8) & 1)) EXTRA_SYNC(); } } SEAM(8);
    if (IN(9)) { for (int _r = 0; _r <= ((DUPMASK >> 9) & 1); ++_r) {
        { SchedPlain S; S.init(ws + WS_OMIX, ws + WS_WOUT, D, D, 32, 8, G, bid); EpiResidB E{Z, XB, 1.0f}; gemm_phase(lds, D, D, D, S, E); }
        { SchedPieces S{(const char*)(ws + WS_OMIX), (const char*)(ws + WS_WOUT), D, D, 8 * 8, G, bid}; EpiPart E{PART}; gemm_phase(lds, D, D, 256, S, E); }
     if (_r < ((DUPMASK >> 9) & 1)) EXTRA_SYNC(); } } SEAM(9);
    if (IN(10)) { for (int _r = 0; _r <= ((DUPMASK >> 10) & 1); ++_r) { phase_ln(lds, Z, p.in[I_LN2G], p.in[I_LN2B], nullptr, XB, G, bid, PART, 8, nullptr, XB + (size_t)MP * D, 1.0f);  if (_r < ((DUPMASK >> 10) & 1)) EXTRA_SYNC(); } } SEAM(10);
    if (IN(11)) { for (int _r = 0; _r <= ((DUPMASK >> 11) & 1); ++_r) {
        { SchedPlain S; S.init(XB, ws + WS_WMQ, D, D, 32, 8, G, bid); EpiBf16 E{(bf16_t*)(ws + WS_Q), D, QSCALE, MP}; gemm_phase(lds, D, D, D, S, E); }
        { SchedPieces S{(const char*)XB, (const char*)(ws + WS_WMQ), D, D, 8 * 8, G, bid}; EpiPart E{PART}; gemm_phase(lds, D, D, 256, S, E); }
     if (_r < ((DUPMASK >> 11) & 1)) EXTRA_SYNC(); } } SEAM(11);
    if (IN(12)) { for (int _r = 0; _r <= ((DUPMASK >> 12) & 1); ++_r) {
        { SchedScores S{(const char*)(ws + WS_Q), (const char*)(ws + WS_KB), G, bid}; EpiSoftmax E{(bf16_t*)(ws + WS_P)}; gemm_phase(lds, D, D, MHD, S, E); }
        for (int it = bid; it < MS * NMH; it += G) samp_attn_item(p, lds, it);
     if (_r < ((DUPMASK >> 12) & 1)) EXTRA_SYNC(); } } SEAM(12);
    if (IN(13)) { for (int _r = 0; _r <= ((DUPMASK >> 13) & 1); ++_r) {
        SchedPV S{(const char*)(ws + WS_P), (const char*)(ws + WS_VT), G, bid}; EpiBf16 E{(bf16_t*)(ws + WS_OA), D, 1.0f, MP}; gemm_phase(lds, 1024, NMEM, NMEM, S, E);
     if (_r < ((DUPMASK >> 13) & 1)) EXTRA_SYNC(); } } SEAM(13);
    if (IN(14)) { for (int _r = 0; _r <= ((DUPMASK >> 14) & 1); ++_r) {
        { SchedPlain S; S.init(ws + WS_OA, ws + WS_WMO, D, D, 32, 8, G, bid); EpiResidB E{Z, XB, 1.0f}; gemm_phase(lds, D, D, D, S, E); }
        { SchedPieces S{(const char*)(ws + WS_OA), (const char*)(ws + WS_WMO), D, D, 8 * 8, G, bid}; EpiPart E{PART}; gemm_phase(lds, D, D, 256, S, E); }
     if (_r < ((DUPMASK >> 14) & 1)) EXTRA_SYNC(); } } SEAM(14);
    if (IN(15)) { for (int _r = 0; _r <= ((DUPMASK >> 15) & 1); ++_r) { phase_ln(lds, Z, p.in[I_LN3G], p.in[I_LN3B], nullptr, XB, G, bid, PART, 8, nullptr, XB + (size_t)MP * D, 1.0f);  if (_r < ((DUPMASK >> 15) & 1)) EXTRA_SYNC(); } } SEAM(15);
    if (IN(16)) { for (int _r = 0; _r <= ((DUPMASK >> 16) & 1); ++_r) {
        SchedPlain S; S.init(XB, ws + WS_W13B, D, D, 33, 44, G, bid); EpiGluH E{Hb}; gemm_phase(lds, D, D, D, S, E);
     if (_r < ((DUPMASK >> 16) & 1)) EXTRA_SYNC(); } } SEAM(16);
    if (IN(17)) { for (int _r = 0; _r <= ((DUPMASK >> 17) & 1); ++_r) {
        { SchedPlain S; S.init(Hb, ws + WS_W2B, FF, FF, 32, 8, G, bid); EpiResidB E{Z, XB, 0.5f}; gemm_phase(lds, FF, FF, FF, S, E); }
        { SchedPieces S{(const char*)Hb, (const char*)(ws + WS_W2B), FF, FF, 8 * 22, G, bid}; EpiPart E{PART}; gemm_phase(lds, FF, FF, 256, S, E); }
     if (_r < ((DUPMASK >> 17) & 1)) EXTRA_SYNC(); } } SEAM(17);
    if (IN(18)) for (int _r = 0; _r <= ((DUPMASK >> 18) & 1); ++_r) { if (_r) EXTRA_SYNC(); phase_ln(lds, Z, p.in[I_LN4G], p.in[I_LN4B], p.out + O_Y, nullptr, G, bid, PART, 22, nullptr, XB + (size_t)MP * D, 0.5f); }
#undef IN
#undef SEAM
}

extern "C" void kernel_launch(void* const* d_in, const int* in_sizes, int n_in, void* d_out, int out_size, void* d_ws, size_t ws_size, hipStream_t stream) {
    static int grid = 0;
    if (grid == 0) {
        if (n_in != N_IN || (size_t)out_size != O_END || ws_size < WS_END) { fprintf(stderr, "kernel_launch: unexpected shapes: n_in %d out %d ws %zu (need %zu)\n", n_in, out_size, ws_size, (size_t)WS_END); grid = -1; return; }
        int dev = 0, cus = 0, per_cu = 0;
        if (hipGetDevice(&dev) != hipSuccess || hipDeviceGetAttribute(&cus, hipDeviceAttributeMultiprocessorCount, dev) != hipSuccess) { fprintf(stderr, "kernel_launch: device query failed\n"); grid = -1; return; }
        if (hipFuncSetAttribute((const void*)fwd_megakernel, hipFuncAttributeMaxDynamicSharedMemorySize, LDS_BYTES) != hipSuccess) { fprintf(stderr, "kernel_launch: hipFuncSetAttribute failed\n"); grid = -1; return; }
        if (hipOccupancyMaxActiveBlocksPerMultiprocessor(&per_cu, (const void*)fwd_megakernel, 512, LDS_BYTES) != hipSuccess || per_cu < 1) { fprintf(stderr, "kernel_launch: occupancy query gives %d\n", per_cu); (void)hipGetLastError(); per_cu = 1; }
        grid = cus * 1;
        if (grid < 128) { fprintf(stderr, "kernel_launch: grid %d too small\n", grid); grid = -1; return; }
    }
    if (grid < 0) return;
    Params p{};
    for (int i = 0; i < N_IN; ++i) p.in[i] = (const float*)d_in[i];
    p.out = (float*)d_out; p.ws = (unsigned char*)d_ws; p.ph_lo = 0; p.ph_hi = NPHASE;
    if (hipMemsetAsync((char*)d_ws + WS_CTL, 0, 16384, stream) != hipSuccess) { fprintf(stderr, "kernel_launch: memset of the barrier words failed\n"); return; }
    void* args[] = {&p};
    hipError_t e = hipLaunchCooperativeKernel((const void*)fwd_megakernel, dim3(grid), dim3(512), args, LDS_BYTES, stream);
    if (e != hipSuccess) fprintf(stderr, "cooperative launch failed: %s (grid %d)\n", hipGetErrorString(e), grid);
}
```

```cpp
#ifndef DUPMASK
#define DUPMASK 0
#endif
#include <hip/hip_runtime.h>
#include <hip/hip_cooperative_groups.h>
#include <cstdio>
#include <cstdint>
namespace cg = cooperative_groups;

#define LAS __attribute__((address_space(3)))
typedef unsigned short bf16_t;
typedef short bf16x8 __attribute__((ext_vector_type(8)));
typedef float f32x4 __attribute__((ext_vector_type(4)));
typedef float f32x2 __attribute__((ext_vector_type(2)));
typedef unsigned u32x4 __attribute__((ext_vector_type(4)));
typedef unsigned u32x2 __attribute__((ext_vector_type(2)));

constexpr int D = 2048, MP = 8192, MS = 128, M = MP + MS, MPAD = 8448, SEQ = 2048, NB = 4;
constexpr int FF = 5632, SC = 3360, DR = 1024, DC = 1024, NH = 16, HD = 64;
constexpr int NMEM = 256, NMH = 4, MHD = 512, CW = 31, LK = 384;
constexpr float ALPHA = 1.189207115002721f;
constexpr float LN_EPS = 1e-5f, GN_EPS = 64e-5f;
constexpr float QSCALE = 0.044194173824159216f;

enum { I_XP = 0, I_XS, I_MEM, I_SSH, I_SCV, I_SWKV, I_CK, I_CV, I_F1W1, I_F1W3, I_F1W2, I_LN1G, I_LN1B, I_WIN, I_MU, I_W0, I_W2D, I_A0, I_A2, I_G2,
       I_KK, I_KA, I_RK, I_GNG, I_GNB, I_CVW, I_CVB, I_CLG, I_CLB, I_BR, I_BC, I_WOUT, I_LN2G, I_LN2B, I_WMQ, I_WMK, I_WMV, I_WMO, I_LN3G, I_LN3B,
       I_F2W1, I_F2W3, I_F2W2, I_LN4G, I_LN4B, N_IN };
constexpr size_t O_Y = 0, O_SHP = (size_t)M * D, O_CVP = O_SHP + (size_t)NB * SC, O_WKP = O_CVP + (size_t)NB * 30 * DC, O_MKP = O_WKP + (size_t)NB * NH * HD * HD,
                 O_MVP = O_MKP + (size_t)NB * NMEM * D, O_SHS = O_MVP + (size_t)NB * NMEM * D, O_CVS = O_SHS + (size_t)MS * SC, O_WKS = O_CVS + (size_t)MS * 30 * DC,
                 O_END = O_WKS + (size_t)MS * NH * HD * HD;
constexpr size_t MiB = 1u << 20;
constexpr size_t WS_W13A = 0, WS_W2A = WS_W13A + 44 * MiB, WS_WIN = WS_W2A + 22 * MiB, WS_WOUT = WS_WIN + 22 * MiB, WS_WMQ = WS_WOUT + 8 * MiB, WS_WMK = WS_WMQ + 8 * MiB,
                 WS_WMV = WS_WMK + 8 * MiB, WS_WMO = WS_WMV + 8 * MiB, WS_W13B = WS_WMO + 8 * MiB, WS_W2B = WS_W13B + 44 * MiB, WS_WLORA = WS_W2B + 22 * MiB,
                 WS_XB = WS_WLORA + 3 * MiB,
                 WS_Z = WS_XB + 33 * MiB,
                 WS_XF = WS_Z + 65 * MiB,
                 WS_RA = WS_XF + 65 * MiB,
                 WS_RB = WS_RA + 107 * MiB,
                 WS_RKV = WS_RB + 98 * MiB,
                 WS_U = WS_RKV + 98 * MiB,
                 WS_LA = WS_U + 33 * MiB,
                 WS_OMIX = WS_LA + 7 * MiB,
                 WS_MEMB = WS_OMIX + 33 * MiB,
                 WS_KB = WS_MEMB + 4 * MiB,
                 WS_VT = WS_KB + 4 * MiB,
                 WS_PART = WS_VT + 4 * MiB,
                 WS_CTL = WS_PART + 23 * MiB,
                 WS_END = WS_CTL + 1 * MiB;
constexpr size_t WS_Y = WS_RKV;
constexpr size_t WS_Q = WS_RA, WS_P = WS_RA + 33 * MiB, WS_OA = WS_RA + 50 * MiB;

constexpr int LDS_BYTES = 131072 + 2048;
constexpr int NPHASE = 19;

struct Params { const float* in[N_IN]; float* out; unsigned char* ws; int ph_lo, ph_hi; };

__device__ __forceinline__ unsigned cvt_pk_bf16(float lo, float hi) { unsigned r; asm("v_cvt_pk_bf16_f32 %0, %1, %2" : "=v"(r) : "v"(lo), "v"(hi)); return r; }
__device__ __forceinline__ bf16_t f2bf(float f) { return (bf16_t)(cvt_pk_bf16(f, f) & 0xffffu); }
__device__ __forceinline__ float bf2f(bf16_t b) { return __builtin_bit_cast(float, (unsigned)b << 16); }
template <int C> __device__ __forceinline__ float dppf(float v) { return __builtin_bit_cast(float, __builtin_amdgcn_update_dpp(0, __builtin_bit_cast(int, v), C, 0xF, 0xF, true)); }
__device__ __forceinline__ float red8(float x) { x += dppf<0xB1>(x); x += dppf<0x4E>(x); x += dppf<0x141>(x); return x; }
__device__ __forceinline__ float red16(float x) { x += dppf<0xB1>(x); x += dppf<0x4E>(x); x += dppf<0x141>(x); x += dppf<0x140>(x); return x; }
__device__ __forceinline__ float swap16_sum(float x) { float a = x, b = x; asm volatile("s_nop 1\n\tv_permlane16_swap_b32 %0, %1" : "+v"(a), "+v"(b)); return a + b; }
__device__ __forceinline__ float swap32_sum(float x) { float a = x, b = x; asm volatile("s_nop 1\n\tv_permlane32_swap_b32 %0, %1" : "+v"(a), "+v"(b)); return a + b; }
__device__ __forceinline__ float wave_sum(float v) { return swap32_sum(swap16_sum(red16(v))); }
__device__ __forceinline__ float wave_max(float v) {
#pragma unroll
    for (int o = 1; o < 64; o <<= 1) v = fmaxf(v, __shfl_xor(v, o));
    return v;
}
__device__ __forceinline__ float sigmoid_f(float x) { return __builtin_amdgcn_rcpf(1.f + __expf(-x)); }
__device__ __forceinline__ float silu_f(float x) { return x * __builtin_amdgcn_rcpf(1.f + __expf(-x)); }

constexpr int BK = 64, HALF = 128, HTB = HALF * BK * 2;
__device__ __forceinline__ int lds_byte(int r, int c) { const int st = (r >> 4) * 2 + (c >> 5), rr = r & 15, cc = c & 31, ob = rr * 64 + cc * 2; return st * 1024 + (ob ^ (((ob >> 9) & 1) << 5)); }
__device__ __forceinline__ void stage_rc(int b, int& R, int& C) { const int st = b / 1024, sb = b % 1024, swz = sb ^ (((sb >> 9) & 1) << 5); R = (st >> 1) * 16 + swz / 64; C = (st & 1) * 32 + (swz % 64) / 2; }
__device__ __forceinline__ int perm32(int rho) { const int n = rho >> 4, i = rho & 15; return 8 * (i >> 2) + 4 * n + (i & 3); }

struct Unit { const char* A; const char* B; int r0, c0, tn; };
typedef f32x4 Acc[2][2][4][2];

struct SchedPlain {
    const char* A; const char* B; int lda, ldb, nM, nN, nwg, G, c;
    __device__ __forceinline__ void init(const void* A_, const void* B_, int lda_, int ldb_, int nM_, int nN_, int G_, int c_) { A = (const char*)A_; B = (const char*)B_; lda = lda_; ldb = ldb_; nM = nM_; nN = nN_; nwg = nM_ * nN_; G = G_; c = c_; }
    __device__ __forceinline__ bool next(int i, Unit& u) const {
        const long L = (long)i * G + c; if (L >= nwg) return false;
        int wgid = (int)L; { const int q = nwg / 8, r = nwg % 8, xcd = wgid % 8, off = wgid / 8; wgid = (xcd < r ? xcd * (q + 1) : r * (q + 1) + (xcd - r) * q) + off; }
        const int nig = 8 * nN, gid = wgid / nig, fm = gid * 8, gsz = (nM - fm) < 8 ? (nM - fm) : 8;
        const int pm = fm + ((wgid % nig) % gsz), pn = (wgid % nig) / gsz;
        u.A = A + (size_t)pm * 256 * lda * 2; u.B = B + (size_t)pn * 256 * ldb * 2; u.r0 = pm * 256; u.c0 = pn * 256; u.tn = pn; return true;
    }
};
struct SchedScores {
    const char* Q; const char* KB; int G, c;
    __device__ __forceinline__ bool next(int i, Unit& u) const {
        const long L = (long)i * G + c; if (L >= 128) return false;
        const int z = (int)L >> 3, pm = (int)L & 7, b = z >> 2, h = z & 3;
        u.A = Q + ((size_t)(b * SEQ + pm * 256) * D + h * MHD) * 2; u.B = KB + ((size_t)(b * NMEM) * D + h * MHD) * 2; u.r0 = b * SEQ + pm * 256; u.c0 = h * NMEM; u.tn = 0; return true;
    }
};
struct SchedPV {
    const char* P; const char* VT; int G, c;
    __device__ __forceinline__ bool next(int i, Unit& u) const {
        const long L = (long)i * G + c; if (L >= 256) return false;
        const int z = (int)L >> 4, pm = ((int)L & 15) >> 1, pn = (int)L & 1, b = z >> 2, h = z & 3;
        u.A = P + ((size_t)(b * SEQ + pm * 256) * 1024 + h * NMEM) * 2; u.B = VT + ((size_t)(b * D + h * MHD + pn * 256) * NMEM) * 2; u.r0 = b * SEQ + pm * 256; u.c0 = h * MHD + pn * 256; u.tn = pn; return true;
    }
};

struct SchedPieces {
    const char* A; const char* B; int lda, ldb, total, G, c;
    __device__ __forceinline__ bool next(int i, Unit& u) const {
        const long L = (long)i * G + c; if (L >= total) return false;
        const int pn = (int)L & 7, sl = (int)L >> 3;
        u.A = A + ((size_t)MP * lda + sl * 256) * 2; u.B = B + ((size_t)pn * 256 * ldb + sl * 256) * 2; u.r0 = MP; u.c0 = pn * 256; u.tn = sl; return true;
    }
};

template <class Epi, class Sched>
__device__ __forceinline__ void gemm_phase(LAS unsigned char* lds, const int lda, const int ldb, const int K, const Sched& S, const Epi& E) {
    const int tid = threadIdx.x, wid = __builtin_amdgcn_readfirstlane(tid >> 6), lane = tid & 63, wr = wid >> 2, wc = wid & 3, fr = lane & 15, fq = lane >> 4;
    const int nt = K / BK;
    unsigned voffA[2], voffB[2];
#pragma unroll
    for (int i = 0; i < 2; ++i) { int R, C; stage_rc(tid * 16 + i * 8192, R, C); const int Rb = (R & ~31) + perm32(R & 31);
        voffA[i] = (unsigned)(R * lda + C) * 2u; voffB[i] = (unsigned)(Rb * ldb + C) * 2u; }
    const size_t kstep = (size_t)(BK * 2);
    const size_t hstepA = (size_t)HALF * lda * 2, hstepB = (size_t)HALF * ldb * 2;
    const unsigned ldsw = (unsigned)wid * 1024u;
    const int aoff = lds_byte(wr * 64 + fr, fq * 8), boff = lds_byte(wc * 32 + fr, fq * 8);
#define G_SA(b, h) (((b) * 2 + (h)) * HTB)
#define G_SB(b, h) ((4 + (b) * 2 + (h)) * HTB)
#define G_STAGE(bufoff, gbase, voff) do { _Pragma("unroll") for (int _i = 0; _i < 2; ++_i) \
        __builtin_amdgcn_global_load_lds((const unsigned*)((const char*)(gbase) + (voff)[_i]), (LAS unsigned*)(lds + (bufoff) + ldsw + _i * 8192), 16, 0, 0); } while (0)
#define G_LDA(dst, b, h) do { _Pragma("unroll") for (int m = 0; m < 4; ++m) _Pragma("unroll") for (int k = 0; k < 2; ++k) dst[m][k] = *(const LAS bf16x8*)(lds + G_SA(b, h) + aoff + m * 2048 + k * 1024); } while (0)
#define G_LDB(dst, b, h) do { _Pragma("unroll") for (int n = 0; n < 2; ++n) _Pragma("unroll") for (int k = 0; k < 2; ++k) dst[n][k] = *(const LAS bf16x8*)(lds + G_SB(b, h) + boff + n * 2048 + k * 1024); } while (0)
#define G_MMA(ai, bj, At, Bt) do { __builtin_amdgcn_s_setprio(1); _Pragma("unroll") for (int m = 0; m < 4; ++m) _Pragma("unroll") for (int n = 0; n < 2; ++n) _Pragma("unroll") for (int k = 0; k < 2; ++k) \
        acc[ai][bj][m][n] = __builtin_amdgcn_mfma_f32_16x16x32_bf16(Bt[n][k], At[m][k], acc[ai][bj][m][n], 0, 0, 0); __builtin_amdgcn_s_setprio(0); } while (0)
#define G_WAIT_V(n) asm volatile("s_waitcnt vmcnt(" #n ")" ::: "memory")
#define G_WAIT_L(n) asm volatile("s_waitcnt lgkmcnt(" #n ")" ::: "memory")
#define G_BAR __builtin_amdgcn_s_barrier()
#define G_SCHED __builtin_amdgcn_sched_barrier(0)
    Unit cur, nxt; int ui = 0;
    if (!S.next(0, cur)) return;
    Acc acc;
#pragma unroll
    for (int a = 0; a < 2; ++a)
#pragma unroll
        for (int b = 0; b < 2; ++b)
#pragma unroll
            for (int m = 0; m < 4; ++m)
#pragma unroll
                for (int n = 0; n < 2; ++n) acc[a][b][m][n] = (f32x4){0.f, 0.f, 0.f, 0.f};
    bf16x8 At[4][2], B0[2][2], B1[2][2];
    const char* cA = cur.A; const char* cB = cur.B;
    G_STAGE(G_SB(0, 0), cB, voffB); G_STAGE(G_SB(0, 1), cB + hstepB, voffB); G_STAGE(G_SA(0, 0), cA, voffA); G_STAGE(G_SA(0, 1), cA + hstepA, voffA);
    if (wr == 1) G_BAR;
    G_WAIT_V(2); G_BAR;
    G_STAGE(G_SB(1, 0), cB + kstep, voffB); G_STAGE(G_SA(1, 0), cA + kstep, voffA); G_STAGE(G_SB(1, 1), cB + hstepB + kstep, voffB);
    G_WAIT_V(6); G_BAR;
    for (;;) {
        const bool has_next = S.next(ui + 1, nxt);
        const char* nA = has_next ? nxt.A : cA; const char* nB = has_next ? nxt.B : cB;
#pragma unroll 1
        for (int t = 0; t < nt; t += 2) {
            const bool last = (t == nt - 2);
            const char* a1 = cA + (size_t)(t + 1) * kstep;
            const char* a2 = last ? nA : cA + (size_t)(t + 2) * kstep; const char* b2 = last ? nB : cB + (size_t)(t + 2) * kstep;
            const char* a3 = a2 + kstep; const char* b3 = b2 + kstep;
            G_LDB(B0, 0, 0); G_LDB(B1, 0, 1); G_SCHED; G_LDA(At, 0, 0); G_STAGE(G_SA(1, 1), a1 + hstepA, voffA);
            G_WAIT_V(8); G_WAIT_L(0); G_BAR; G_MMA(0, 0, At, B0); G_MMA(0, 1, At, B1); G_BAR; G_SCHED;
            G_LDA(At, 0, 1); G_STAGE(G_SB(0, 0), b2, voffB); G_STAGE(G_SB(0, 1), b2 + hstepB, voffB); G_STAGE(G_SA(0, 0), a2, voffA);
            G_WAIT_V(8); G_WAIT_L(0); G_BAR; G_MMA(1, 0, At, B0); G_MMA(1, 1, At, B1); G_BAR; G_SCHED;
            G_LDB(B0, 1, 0); G_LDB(B1, 1, 1); G_SCHED; G_LDA(At, 1, 0); G_STAGE(G_SA(0, 1), a2 + hstepA, voffA);
            G_WAIT_V(8); G_WAIT_L(0); G_BAR; G_MMA(0, 0, At, B0); G_MMA(0, 1, At, B1); G_BAR; G_SCHED;
            G_LDA(At, 1, 1); G_STAGE(G_SB(1, 0), b3, voffB); G_STAGE(G_SB(1, 1), b3 + hstepB, voffB); G_STAGE(G_SA(1, 0), a3, voffA);
            G_WAIT_V(8); G_WAIT_L(0); G_BAR; G_MMA(1, 0, At, B0); G_MMA(1, 1, At, B1); G_BAR; G_SCHED;
        }
        if (wr == 0) G_BAR;
        if constexpr (!Epi::AFTER_DRAIN) E(acc, cur, wr, wc, fr, fq);
        if (!has_next) break;
#pragma unroll
        for (int a = 0; a < 2; ++a)
#pragma unroll
            for (int b = 0; b < 2; ++b)
#pragma unroll
                for (int m = 0; m < 4; ++m)
#pragma unroll
                    for (int n = 0; n < 2; ++n) acc[a][b][m][n] = (f32x4){0.f, 0.f, 0.f, 0.f};
        cur = nxt; cA = nA; cB = nB; ++ui;
        if (wr == 1) G_BAR;
    }
    G_WAIT_V(0);
    G_BAR;
    if constexpr (Epi::AFTER_DRAIN) E.fused(acc, cur, wr, wc, fr, fq, lds);
#undef G_SA
#undef G_SB
#undef G_STAGE
#undef G_LDA
#undef G_LDB
#undef G_MMA
#undef G_WAIT_V
#undef G_WAIT_L
#undef G_BAR
#undef G_SCHED
}

struct EpiGluH {
    static constexpr bool AFTER_DRAIN = false;
    bf16_t* H;
    __device__ __forceinline__ void operator()(Acc& acc, const Unit& u, int wr, int wc, int fr, int fq) const {
#pragma unroll
        for (int ai = 0; ai < 2; ++ai)
#pragma unroll
            for (int m = 0; m < 4; ++m) {
                const int r = u.r0 + 128 * ai + 64 * wr + 16 * m + fr;
                if (r < M) {
                    float h[8];
#pragma unroll
                    for (int n = 0; n < 2; ++n)
#pragma unroll
                        for (int j = 0; j < 4; ++j) h[4 * n + j] = silu_f(acc[ai][0][m][n][j]) * acc[ai][1][m][n][j];
                    u32x4 w; w.x = cvt_pk_bf16(h[0], h[1]); w.y = cvt_pk_bf16(h[2], h[3]); w.z = cvt_pk_bf16(h[4], h[5]); w.w = cvt_pk_bf16(h[6], h[7]);
                    *(u32x4*)(H + (size_t)r * FF + 128 * u.tn + 32 * wc + 8 * fq) = w;
                }
            }
    }
};
struct EpiResid {
    static constexpr bool AFTER_DRAIN = false;
    bf16_t* Z; const float* res0; const float* res1; float scale;
    __device__ __forceinline__ void operator()(Acc& acc, const Unit& u, int wr, int wc, int fr, int fq) const {
#pragma unroll
        for (int ai = 0; ai < 2; ++ai)
#pragma unroll
            for (int m = 0; m < 4; ++m) {
                const int r = u.r0 + 128 * ai + 64 * wr + 16 * m + fr;
                if (r < M) {
                    const float* rp = (r < MP) ? res0 + (size_t)r * D : res1 + (size_t)(r - MP) * D;
                    bf16_t* zp = Z + (size_t)r * D;
#pragma unroll
                    for (int bj = 0; bj < 2; ++bj) {
                        const int c = u.c0 + 128 * bj + 32 * wc + 8 * fq;
                        const f32x4 v0 = *(const f32x4*)(rp + c) * ALPHA + acc[ai][bj][m][0] * scale, v1 = *(const f32x4*)(rp + c + 4) * ALPHA + acc[ai][bj][m][1] * scale;
                        u32x4 w; w.x = cvt_pk_bf16(v0[0], v0[1]); w.y = cvt_pk_bf16(v0[2], v0[3]); w.z = cvt_pk_bf16(v1[0], v1[1]); w.w = cvt_pk_bf16(v1[2], v1[3]);
                        *(u32x4*)(zp + c) = w;
                    }
                }
            }
    }
};
struct EpiResidB {
    static constexpr bool AFTER_DRAIN = false;
    bf16_t* Z; const bf16_t* res; float scale;
    __device__ __forceinline__ void operator()(Acc& acc, const Unit& u, int wr, int wc, int fr, int fq) const {
#pragma unroll
        for (int ai = 0; ai < 2; ++ai)
#pragma unroll
            for (int m = 0; m < 4; ++m) {
                const int r = u.r0 + 128 * ai + 64 * wr + 16 * m + fr;
                const bf16_t* rp = res + (size_t)r * D; bf16_t* zp = Z + (size_t)r * D;
#pragma unroll
                for (int bj = 0; bj < 2; ++bj) {
                    const int c = u.c0 + 128 * bj + 32 * wc + 8 * fq;
                    const u32x4 rb = *(const u32x4*)(rp + c);
                    f32x4 r0, r1;
                    r0[0] = __builtin_bit_cast(float, rb[0] << 16); r0[1] = __builtin_bit_cast(float, rb[0] & 0xffff0000u); r0[2] = __builtin_bit_cast(float, rb[1] << 16); r0[3] = __builtin_bit_cast(float, rb[1] & 0xffff0000u);
                    r1[0] = __builtin_bit_cast(float, rb[2] << 16); r1[1] = __builtin_bit_cast(float, rb[2] & 0xffff0000u); r1[2] = __builtin_bit_cast(float, rb[3] << 16); r1[3] = __builtin_bit_cast(float, rb[3] & 0xffff0000u);
                    const f32x4 v0 = r0 * ALPHA + acc[ai][bj][m][0] * scale, v1 = r1 * ALPHA + acc[ai][bj][m][1] * scale;
                    u32x4 w; w.x = cvt_pk_bf16(v0[0], v0[1]); w.y = cvt_pk_bf16(v0[2], v0[3]); w.z = cvt_pk_bf16(v1[0], v1[1]); w.w = cvt_pk_bf16(v1[2], v1[3]);
                    *(u32x4*)(zp + c) = w;
                }
            }
    }
};
struct EpiPart {
    static constexpr bool AFTER_DRAIN = false;
    float* PART;
    __device__ __forceinline__ void operator()(Acc& acc, const Unit& u, int wr, int wc, int fr, int fq) const {
#pragma unroll
        for (int m = 0; m < 4; ++m) {
            const int rl = 64 * wr + 16 * m + fr;
            float* pp = PART + ((size_t)u.tn * 128 + rl) * D;
#pragma unroll
            for (int bj = 0; bj < 2; ++bj)
#pragma unroll
                for (int n = 0; n < 2; ++n) *(f32x4*)(pp + u.c0 + 128 * bj + 32 * wc + 8 * fq + 4 * n) = acc[0][bj][m][n];
        }
    }
};
struct EpiWin {
    static constexpr bool AFTER_DRAIN = false;
    float* PS; float* U;
    __device__ __forceinline__ void operator()(Acc& acc, const Unit& u, int wr, int wc, int fr, int fq) const {
#pragma unroll
        for (int ai = 0; ai < 2; ++ai)
#pragma unroll
            for (int m = 0; m < 4; ++m) {
                const int r = u.r0 + 128 * ai + 64 * wr + 16 * m + fr;
                if (r < M) {
                    if (u.tn < 14) {
#pragma unroll
                        for (int bj = 0; bj < 2; ++bj)
#pragma unroll
                            for (int n = 0; n < 2; ++n) {
                                const int c = u.c0 + 128 * bj + 32 * wc + 8 * fq + 4 * n;
                                if (c < SC) *(f32x4*)(PS + (size_t)r * SC + c) = acc[ai][bj][m][n];
                            }
                    } else {
#pragma unroll
                        for (int n = 0; n < 2; ++n) {
                            const int c = 128 * (u.tn - 14) + 32 * wc + 8 * fq + 4 * n;
                            f32x4 o;
#pragma unroll
                            for (int j = 0; j < 4; ++j) o[j] = acc[ai][0][m][n][j] * sigmoid_f(acc[ai][1][m][n][j]);
                            *(f32x4*)(U + (size_t)r * DC + c) = o;
                        }
                    }
                }
            }
    }
};
struct EpiLora {
    static constexpr bool AFTER_DRAIN = false;
    float* DAG; const float* w0; const float* a0;
    __device__ __forceinline__ void operator()(Acc& acc, const Unit& u, int wr, int wc, int fr, int fq) const {
        const int sec = u.tn >> 2;
#pragma unroll
        for (int ai = 0; ai < 2; ++ai)
#pragma unroll
            for (int m = 0; m < 4; ++m) {
                const int r = u.r0 + 128 * ai + 64 * wr + 16 * m + fr;
                if (r < M) {
#pragma unroll
                    for (int bj = 0; bj < 2; ++bj)
#pragma unroll
                        for (int n = 0; n < 2; ++n) {
                            const int c = u.c0 + 128 * bj + 32 * wc + 8 * fq + 4 * n, cc = c & 1023;
                            f32x4 o = acc[ai][bj][m][n];
                            if (sec == 0) {
                                const f32x4 wv = *(const f32x4*)(w0 + cc);
#pragma unroll
                                for (int j = 0; j < 4; ++j) o[j] = __expf(-0.6065306597126334f * sigmoid_f(wv[j] + o[j]));
                            } else if (sec == 1) {
                                const f32x4 av = *(const f32x4*)(a0 + cc);
#pragma unroll
                                for (int j = 0; j < 4; ++j) o[j] = sigmoid_f(av[j] + o[j]);
                            }
                            *(f32x4*)(DAG + (size_t)r * 3072 + c) = o;
                        }
                }
            }
    }
};
struct EpiBf16 {
    static constexpr bool AFTER_DRAIN = false;
    bf16_t* O; int ldc; float scale; int rlim;
    __device__ __forceinline__ void operator()(Acc& acc, const Unit& u, int wr, int wc, int fr, int fq) const {
#pragma unroll
        for (int ai = 0; ai < 2; ++ai)
#pragma unroll
            for (int m = 0; m < 4; ++m) {
                const int r = u.r0 + 128 * ai + 64 * wr + 16 * m + fr;
                if (r < rlim) {
#pragma unroll
                    for (int bj = 0; bj < 2; ++bj) {
                        const f32x4 v0 = acc[ai][bj][m][0] * scale, v1 = acc[ai][bj][m][1] * scale;
                        u32x4 w; w.x = cvt_pk_bf16(v0[0], v0[1]); w.y = cvt_pk_bf16(v0[2], v0[3]); w.z = cvt_pk_bf16(v1[0], v1[1]); w.w = cvt_pk_bf16(v1[2], v1[3]);
                        *(u32x4*)(O + (size_t)r * ldc + u.c0 + 128 * bj + 32 * wc + 8 * fq) = w;
                    }
                }
            }
    }
};
struct EpiMemKV {
    static constexpr bool AFTER_DRAIN = false;
    float* outK; float* outV; bf16_t* KB; bf16_t* VT;
    __device__ __forceinline__ void operator()(Acc& acc, const Unit& u, int wr, int wc, int fr, int fq) const {
#pragma unroll
        for (int ai = 0; ai < 2; ++ai)
#pragma unroll
            for (int m = 0; m < 4; ++m) {
                const int r = u.r0 + 128 * ai + 64 * wr + 16 * m + fr;
#pragma unroll
                for (int bj = 0; bj < 2; ++bj) {
                    const int c = u.c0 + 128 * bj + 32 * wc + 8 * fq;
                    const f32x4 v0 = acc[ai][bj][m][0], v1 = acc[ai][bj][m][1];
                    if (u.tn < 8) {
                        __builtin_nontemporal_store(v0, (f32x4*)(outK + (size_t)r * D + c)); __builtin_nontemporal_store(v1, (f32x4*)(outK + (size_t)r * D + c + 4));
                        u32x4 w; w.x = cvt_pk_bf16(v0[0], v0[1]); w.y = cvt_pk_bf16(v0[2], v0[3]); w.z = cvt_pk_bf16(v1[0], v1[1]); w.w = cvt_pk_bf16(v1[2], v1[3]);
                        *(u32x4*)(KB + (size_t)r * D + c) = w;
                    } else {
                        const int cv = c - D;
                        __builtin_nontemporal_store(v0, (f32x4*)(outV + (size_t)r * D + cv)); __builtin_nontemporal_store(v1, (f32x4*)(outV + (size_t)r * D + cv + 4));
                        bf16_t* vt = VT + ((size_t)(r >> 8) * D + cv) * NMEM + (r & 255);
#pragma unroll
                        for (int j = 0; j < 4; ++j) { vt[(size_t)j * NMEM] = f2bf(v0[j]); vt[(size_t)(4 + j) * NMEM] = f2bf(v1[j]); }
                    }
                }
            }
    }
};
struct EpiSoftmax {
    static constexpr bool AFTER_DRAIN = true;
    bf16_t* P;
    __device__ __forceinline__ void operator()(Acc&, const Unit&, int, int, int, int) const {}
    __device__ __forceinline__ void fused(Acc& acc, const Unit& u, int wr, int wc, int fr, int fq, LAS unsigned char* lds) const {
        LAS float* red = (LAS float*)lds;
        LAS float* red2 = red + 1024;
#pragma unroll
        for (int ai = 0; ai < 2; ++ai)
#pragma unroll
            for (int m = 0; m < 4; ++m) {
                float v = -3.0e38f;
#pragma unroll
                for (int bj = 0; bj < 2; ++bj)
#pragma unroll
                    for (int n = 0; n < 2; ++n)
#pragma unroll
                        for (int j = 0; j < 4; ++j) v = fmaxf(v, acc[ai][bj][m][n][j]);
                v = fmaxf(v, __shfl_xor(v, 16)); v = fmaxf(v, __shfl_xor(v, 32));
                if (fq == 0) red[wc * 256 + 128 * ai + 64 * wr + 16 * m + fr] = v;
            }
        __syncthreads();
#pragma unroll
        for (int ai = 0; ai < 2; ++ai)
#pragma unroll
            for (int m = 0; m < 4; ++m) {
                const int rl = 128 * ai + 64 * wr + 16 * m + fr;
                const float mx = fmaxf(fmaxf(red[rl], red[256 + rl]), fmaxf(red[512 + rl], red[768 + rl]));
                float s = 0.f;
#pragma unroll
                for (int bj = 0; bj < 2; ++bj)
#pragma unroll
                    for (int n = 0; n < 2; ++n)
#pragma unroll
                        for (int j = 0; j < 4; ++j) { const float e = __expf(acc[ai][bj][m][n][j] - mx); acc[ai][bj][m][n][j] = e; s += e; }
                s += __shfl_xor(s, 16); s += __shfl_xor(s, 32);
                if (fq == 0) red2[wc * 256 + rl] = s;
            }
        __syncthreads();
#pragma unroll
        for (int ai = 0; ai < 2; ++ai)
#pragma unroll
            for (int m = 0; m < 4; ++m) {
                const int rl = 128 * ai + 64 * wr + 16 * m + fr;
                const float inv = 1.f / ((red2[rl] + red2[256 + rl]) + (red2[512 + rl] + red2[768 + rl]));
#pragma unroll
                for (int bj = 0; bj < 2; ++bj) {
                    const f32x4 v0 = acc[ai][bj][m][0] * inv, v1 = acc[ai][bj][m][1] * inv;
                    u32x4 w; w.x = cvt_pk_bf16(v0[0], v0[1]); w.y = cvt_pk_bf16(v0[2], v0[3]); w.z = cvt_pk_bf16(v1[0], v1[1]); w.w = cvt_pk_bf16(v1[2], v1[3]);
                    *(u32x4*)(P + (size_t)(u.r0 + rl) * 1024 + u.c0 + 128 * bj + 32 * wc + 8 * fq) = w;
                }
            }
        __syncthreads();
    }
};

__device__ __forceinline__ void transpose_item(const float* W, int K, int N, bf16_t* WT, int k0, int n0, int drow0, LAS float* scr, int lane, bool late = false) {
    float tv[32];
#pragma unroll
    for (int i = 0; i < 32; ++i) tv[i] = __builtin_nontemporal_load(W + (size_t)(k0 + 2 * i + (lane >> 5)) * N + n0 + (lane & 31));
#pragma unroll
    for (int i = 0; i < 32; ++i) scr[(2 * i + (lane >> 5)) * 33 + (lane & 31)] = tv[i];
    asm volatile("s_waitcnt lgkmcnt(0)" ::: "memory");
    const int c = lane & 7;
#pragma unroll
    for (int j = 0; j < 4; ++j) { const int n = (lane >> 3) + 8 * j; const LAS float* s = scr + (8 * c) * 33 + n;
        u32x4 o; o.x = cvt_pk_bf16(s[0 * 33], s[1 * 33]); o.y = cvt_pk_bf16(s[2 * 33], s[3 * 33]); o.z = cvt_pk_bf16(s[4 * 33], s[5 * 33]); o.w = cvt_pk_bf16(s[6 * 33], s[7 * 33]);
        if (late) __builtin_nontemporal_store(o, (u32x4*)(WT + (size_t)(drow0 + n) * K + k0 + 8 * c)); else *(u32x4*)(WT + (size_t)(drow0 + n) * K + k0 + 8 * c) = o; }
    asm volatile("s_waitcnt lgkmcnt(0)" ::: "memory");
}
__device__ __forceinline__ int glu_row(int n0, int which) { return (n0 >> 7) * 256 + which * 128 + (n0 & 127); }
__device__ __forceinline__ int win_row(int n0) {
    if (n0 < SC) return n0;
    if (n0 < SC + DC) return 3584 + glu_row(n0 - SC, 0);
    return 3584 + glu_row(n0 - SC - DC, 1);
}
__device__ __forceinline__ void phase_prep(const Params& p, LAS unsigned char* lds, int G, int bid) {
    const int tid = threadIdx.x, lane = tid & 63, wid = tid >> 6;
    const int gw = bid * 8 + wid, NGW = G * 8;
    LAS float* scr = (LAS float*)(lds + wid * 8704);
    unsigned char* ws = p.ws;
    constexpr int I_FF = (D / 64) * (FF / 32);
    constexpr int I_IN = (D / 64) * (5408 / 32);
    constexpr int I_SQ = (D / 64) * (D / 32);
    constexpr int NITEMS = 6 * I_FF + I_IN + 5 * I_SQ;
    for (int it = gw; it < NITEMS; it += NGW) {
        int r = NITEMS - 1 - it;
        if (r < 6 * I_FF) {
            const int which = r / I_FF; r -= which * I_FF;
            const int layer = which / 3, kind = which % 3;
            if (kind < 2) {
                const float* W = p.in[layer ? (kind ? I_F2W3 : I_F2W1) : (kind ? I_F1W3 : I_F1W1)];
                bf16_t* WT = (bf16_t*)(ws + (layer ? WS_W13B : WS_W13A));
                const int nblk = FF / 32, kb = r / nblk, nb = r % nblk;
                transpose_item(W, D, FF, WT, kb * 64, nb * 32, glu_row(nb * 32, kind), scr, lane, layer != 0);
            } else {
                const float* W = p.in[layer ? I_F2W2 : I_F1W2];
                bf16_t* WT = (bf16_t*)(ws + (layer ? WS_W2B : WS_W2A));
                const int nblk = D / 32, kb = r / nblk, nb = r % nblk;
                transpose_item(W, FF, D, WT, kb * 64, nb * 32, nb * 32, scr, lane, layer != 0);
            }
            continue;
        }
        r -= 6 * I_FF;
        if (r < I_IN) {
            const int nblk = 5408 / 32, kb = r / nblk, nb = r % nblk;
            transpose_item(p.in[I_WIN], D, 5408, (bf16_t*)(ws + WS_WIN), kb * 64, nb * 32, win_row(nb * 32), scr, lane);
            continue;
        }
        r -= I_IN;
        {
            const int which = r / I_SQ; r -= which * I_SQ;
            const int idx = which == 0 ? I_WOUT : which == 1 ? I_WMQ : which == 2 ? I_WMK : which == 3 ? I_WMV : I_WMO;
            const size_t off = which == 0 ? WS_WOUT : which == 1 ? WS_WMQ : which == 2 ? WS_WMK : which == 3 ? WS_WMV : WS_WMO;
            const int nblk = D / 32, kb = r / nblk, nb = r % nblk;
            transpose_item(p.in[idx], D, D, (bf16_t*)(ws + off), kb * 64, nb * 32, nb * 32, scr, lane, which != 2 && which != 3);
        }
    }
    const int gt = bid * 512 + tid, NGT = G * 512;
    { u32x4* z = (u32x4*)(ws + WS_WIN + (size_t)SC * D * 2); const int n16 = (3584 - SC) * D * 2 / 16;
      for (int i = gt; i < n16; i += NGT) z[i] = (u32x4){0u, 0u, 0u, 0u}; }
    { bf16_t* WL = (bf16_t*)(ws + WS_WLORA);
      for (int i = gt; i < 3072 * LK; i += NGT) {
          const int n = i / LK, k = i % LK; float v = 0.f;
          if (n < 1024) { if (k < 64) v = p.in[I_W2D][(size_t)k * DR + n]; }
          else if (n < 2048) { if (k >= 64 && k < 128) v = p.in[I_A2][(size_t)(k - 64) * DR + (n - 1024)]; }
          else { if (k >= 128 && k < 288) v = p.in[I_G2][(size_t)(k - 128) * DR + (n - 2048)]; }
          WL[i] = f2bf(v);
      } }
    { u32x2* xb = (u32x2*)(ws + WS_XB); const f32x4* xp = (const f32x4*)p.in[I_XP]; const f32x4* xs = (const f32x4*)p.in[I_XS];
      constexpr int NP4 = MP * D / 4, NA4 = M * D / 4;
      for (int i = gt; i < NA4; i += NGT) { const f32x4 v = (i < NP4) ? xp[i] : xs[i - NP4]; xb[i] = (u32x2){cvt_pk_bf16(v[0], v[1]), cvt_pk_bf16(v[2], v[3])}; }
      u32x2* mb = (u32x2*)(ws + WS_MEMB); const f32x4* mp = (const f32x4*)p.in[I_MEM];
      for (int i = gt; i < 1024 * D / 4; i += NGT) { const f32x4 v = mp[i]; mb[i] = (u32x2){cvt_pk_bf16(v[0], v[1]), cvt_pk_bf16(v[2], v[3])}; } }
}

__device__ __forceinline__ void ln_finish(f32x4 (&v)[8], int row, int lane, const float* g, const float* b, float* outF, bf16_t* outB) {
    float s = 0.f;
#pragma unroll
    for (int j = 0; j < 8; ++j) s += (v[j][0] + v[j][1]) + (v[j][2] + v[j][3]);
    const float mean = wave_sum(s) * (1.f / D); float s2 = 0.f;
#pragma unroll
    for (int j = 0; j < 8; ++j) { v[j] = v[j] - mean; s2 += (v[j][0] * v[j][0] + v[j][1] * v[j][1]) + (v[j][2] * v[j][2] + v[j][3] * v[j][3]); }
    const float rstd = 1.f / sqrtf(wave_sum(s2) * (1.f / D) + LN_EPS);
#pragma unroll
    for (int j = 0; j < 8; ++j) {
        const f32x4 gv = ((const f32x4*)g)[64 * j + lane], bv = ((const f32x4*)b)[64 * j + lane];
        const f32x4 y = v[j] * rstd * gv + bv;
        if (outF) __builtin_nontemporal_store(y, (f32x4*)(outF + (size_t)row * D) + 64 * j + lane);
        if (outB) ((u32x2*)(outB + (size_t)row * D))[64 * j + lane] = (u32x2){cvt_pk_bf16(y[0], y[1]), cvt_pk_bf16(y[2], y[3])};
    }
}
__device__ __forceinline__ void phase_ln(LAS unsigned char* lds, const bf16_t* Z, const float* g, const float* b, float* outF, bf16_t* outB, int G, int bid, const float* PART, int nsl, const float* res1, const bf16_t* res1b, float scale) {
    const int tid = threadIdx.x, lane = tid & 63, wid = tid >> 6;
    const int gw = bid * 8 + wid, NGW = G * 8;
    {
        f32x4 cur[8], nxt[8];
        int row = gw;
        if (row < MP) {
#pragma unroll
            for (int j = 0; j < 8; ++j) { const u32x2 zb = ((const u32x2*)(Z + (size_t)row * D))[64 * j + lane]; cur[j][0] = __builtin_bit_cast(float, zb[0] << 16); cur[j][1] = __builtin_bit_cast(float, zb[0] & 0xffff0000u); cur[j][2] = __builtin_bit_cast(float, zb[1] << 16); cur[j][3] = __builtin_bit_cast(float, zb[1] & 0xffff0000u); }
        }
#pragma unroll 1
        while (row < MP) {
            const int nrow = row + NGW;
            if (nrow < MP) {
#pragma unroll
                for (int j = 0; j < 8; ++j) { const u32x2 zb = ((const u32x2*)(Z + (size_t)nrow * D))[64 * j + lane]; nxt[j][0] = __builtin_bit_cast(float, zb[0] << 16); nxt[j][1] = __builtin_bit_cast(float, zb[0] & 0xffff0000u); nxt[j][2] = __builtin_bit_cast(float, zb[1] << 16); nxt[j][3] = __builtin_bit_cast(float, zb[1] & 0xffff0000u); }
            }
            ln_finish(cur, row, lane, g, b, outF, outB);
#pragma unroll
            for (int j = 0; j < 8; ++j) cur[j] = nxt[j];
            row = nrow;
        }
    }
    if (bid < MS) {
        const int sr = bid;
        LAS float* red = (LAS float*)lds;
        f32x4 a = (f32x4){0.f, 0.f, 0.f, 0.f};
#pragma unroll
        for (int sl = 0; sl < 22; ++sl) if (sl < nsl) a += ((const f32x4*)(PART + ((size_t)sl * 128 + sr) * D))[64 * wid + lane];
        f32x4 rv;
        if (res1) rv = ((const f32x4*)(res1 + (size_t)sr * D))[64 * wid + lane];
        else { const u32x2 rb = ((const u32x2*)(res1b + (size_t)sr * D))[64 * wid + lane];
               rv[0] = __builtin_bit_cast(float, rb[0] << 16); rv[1] = __builtin_bit_cast(float, rb[0] & 0xffff0000u); rv[2] = __builtin_bit_cast(float, rb[1] << 16); rv[3] = __builtin_bit_cast(float, rb[1] & 0xffff0000u); }
        f32x4 v = rv * ALPHA + a * scale;
        const float ps = wave_sum((v[0] + v[1]) + (v[2] + v[3]));
        if (lane == 0) red[wid] = ps;
        __syncthreads();
        const float mean = (((red[0] + red[1]) + (red[2] + red[3])) + ((red[4] + red[5]) + (red[6] + red[7]))) * (1.f / D);
        v = v - mean;
        const float ps2 = wave_sum((v[0] * v[0] + v[1] * v[1]) + (v[2] * v[2] + v[3] * v[3]));
        if (lane == 0) red[8 + wid] = ps2;
        __syncthreads();
        const float rstd = 1.f / sqrtf((((red[8] + red[9]) + (red[10] + red[11])) + ((red[12] + red[13]) + (red[14] + red[15]))) * (1.f / D) + LN_EPS);
        const f32x4 gv = ((const f32x4*)g)[64 * wid + lane], bv = ((const f32x4*)b)[64 * wid + lane];
        const f32x4 y = v * rstd * gv + bv;
        if (outF) __builtin_nontemporal_store(y, (f32x4*)(outF + (size_t)(MP + sr) * D) + 64 * wid + lane);
        if (outB) ((u32x2*)(outB + (size_t)(MP + sr) * D))[64 * wid + lane] = (u32x2){cvt_pk_bf16(y[0], y[1]), cvt_pk_bf16(y[2], y[3])};
        __syncthreads();
    }
}

__device__ __forceinline__ void load_rkv_raw(const Params& p, int row, int ch, float (&c)[3], float (&q)[3]) {
    const float* PS = (const float*)(p.ws + WS_RA);
    const float* cur = PS + (size_t)row * SC;
    const float* prev;
    if (row < MP) { const int t = row & (SEQ - 1); prev = PS + (size_t)(row - (t ? 1 : 0)) * SC; }
    else prev = p.in[I_SSH] + (size_t)(row - MP) * SC;
    c[0] = cur[ch]; c[1] = cur[1024 + ch]; c[2] = cur[2048 + ch];
    q[0] = prev[ch]; q[1] = prev[1024 + ch]; q[2] = prev[2048 + ch];
}
__device__ __forceinline__ void load_rkv_cur(const Params& p, int row, int ch, float (&c)[3]) {
    const float* cur = (const float*)(p.ws + WS_RA) + (size_t)row * SC;
    c[0] = cur[ch]; c[1] = cur[1024 + ch]; c[2] = cur[2048 + ch];
}
__device__ __forceinline__ void load_rkv_prev(const Params& p, int row, int ch, float (&q)[3]) {
    const int t = row & (SEQ - 1);
    const float* prev = (const float*)(p.ws + WS_RA) + (size_t)(row - (t ? 1 : 0)) * SC;
    q[0] = prev[ch]; q[1] = prev[1024 + ch]; q[2] = prev[2048 + ch];
}
__device__ __forceinline__ float shift_mix(float c, float q, float mu, bool zprev) { const float pq = zprev ? 0.f : q; return c + mu * (pq - c); }
__device__ __forceinline__ void phase_mixpre(const Params& p, int G, int bid) {
    const int tid = threadIdx.x, lane = tid & 63, wid = tid >> 6;
    const int gw = bid * 8 + wid, NGW = G * 8;
    unsigned char* ws = p.ws;
    const float* PS = (const float*)(ws + WS_RA); bf16_t* LA = (bf16_t*)(ws + WS_LA);
    const float* mu = p.in[I_MU];
    for (int row = gw; row < M; row += NGW) {
        const f32x4* cur = (const f32x4*)(PS + (size_t)row * SC);
        const f32x4* prev; bool zprev = false; float* shout = nullptr;
        if (row < MP) { const int t = row & (SEQ - 1); zprev = (t == 0); prev = (const f32x4*)(PS + (size_t)(row - (zprev ? 0 : 1)) * SC);
                        if (t == SEQ - 1) shout = p.out + O_SHP + (size_t)(row >> 11) * SC; }
        else { prev = (const f32x4*)(p.in[I_SSH] + (size_t)(row - MP) * SC); shout = p.out + O_SHS + (size_t)(row - MP) * SC; }
        if (shout) for (int i = lane; i < SC / 4; i += 64) ((f32x4*)shout)[i] = cur[i];
        for (int i = 768 + lane; i < SC / 4; i += 64) {
            const f32x4 c = cur[i]; f32x4 pv = prev[i]; if (zprev) pv = (f32x4){0.f, 0.f, 0.f, 0.f};
            const f32x4 m4 = ((const f32x4*)mu)[i];
            const f32x4 pm = c + m4 * (pv - c);
            const int col = 4 * i;
            f32x4 a;
            if (col < 3136) { for (int j = 0; j < 4; ++j) a[j] = tanhf(pm[j]); }
            else if (col < 3200) a = pm;
            else { for (int j = 0; j < 4; ++j) a[j] = 1.f / (1.f + expf(-pm[j])); }
            *(u32x2*)(LA + (size_t)row * LK + (col - 3072)) = (u32x2){cvt_pk_bf16(a[0], a[1]), cvt_pk_bf16(a[2], a[3])};
        }
        if (lane < 24) *(u32x2*)(LA + (size_t)row * LK + 288 + 4 * lane) = (u32x2){0u, 0u};
    }
    const int gt = bid * 512 + tid, NGT = G * 512;
    const f32x4* U4 = (const f32x4*)(ws + WS_U);
    { f32x4* o = (f32x4*)(p.out + O_CVP);
      for (int i = gt; i < NB * 30 * DC / 4; i += NGT) { const int c4 = i & 255, j = (i >> 8) % 30, b = (i >> 8) / 30; __builtin_nontemporal_store(U4[(size_t)(b * SEQ + SEQ - 30 + j) * 256 + c4], o + i); } }
    { f32x4* o = (f32x4*)(p.out + O_CVS); const f32x4* sc = (const f32x4*)p.in[I_SCV];
      for (int i = gt; i < MS * 30 * DC / 4; i += NGT) { const int c4 = i & 255, j = (i >> 8) % 30, s = (i >> 8) / 30;
          const f32x4 val = (j < 29) ? sc[(size_t)(s * 30 + j + 1) * 256 + c4] : U4[(size_t)(MP + s) * 256 + c4]; __builtin_nontemporal_store(val, o + i); } }
}

constexpr int TC = 32;
__device__ __forceinline__ void rwkv_sample8(const Params& p, LAS unsigned char* lds, int j0) {
    LAS float* sR = (LAS float*)lds; LAS float* sK = sR + 8 * 64; LAS float* sV = sK + 8 * 64; LAS float* sW = sV + 8 * 64;
    LAS float* sKK = sW + 8 * 64; LAS float* sB = sKK + 8 * 64; LAS float* sY = sB + 8 * 64;
    const int tid = threadIdx.x, lane = tid & 63, wid = tid >> 6;
    const int v = wid * 8 + (lane >> 3), kq = lane & 7;
    const float* DAG = (const float*)(p.ws + WS_RB); bf16_t* OMIX = (bf16_t*)(p.ws + WS_OMIX);
    const int jw = j0 + wid, sw = jw >> 4, hw = jw & 15, roww = MP + sw, ch = hw * 64 + lane;
    const float rk_w = p.in[I_RK][ch], gng = p.in[I_GNG][ch], gnb = p.in[I_GNB][ch], beta = p.in[I_BR][ch];
    {
        const float mu_r = p.in[I_MU][ch], mu_k = p.in[I_MU][1024 + ch], mu_v = p.in[I_MU][2048 + ch], kk_w = p.in[I_KK][ch], ka_w = p.in[I_KA][ch];
        const float* dag = DAG + (size_t)roww * 3072;
        float cc[3], qq[3]; load_rkv_raw(p, roww, ch, cc, qq);
        const float r = shift_mix(cc[0], qq[0], mu_r, false), k = shift_mix(cc[1], qq[1], mu_k, false), vv = shift_mix(cc[2], qq[2], mu_v, false), w = dag[ch], a = dag[1024 + ch];
        const float kr = k * kk_w; const float n2 = wave_sum(kr * kr); const float kk = kr / fmaxf(sqrtf(n2), 1e-12f);
        const float kp = k * (1.f + (a - 1.f) * ka_w);
        const int o = wid * 64 + lane;
        sR[o] = r; sK[o] = kp; sV[o] = vv; sW[o] = w; sKK[o] = kk; sB[o] = kk * a;
    }
    f32x4 Sa[8], Sb[8];
#pragma unroll
    for (int q = 0; q < 8; ++q) { const float* st = p.in[I_SWKV] + (size_t)(j0 + q) * HD * HD + v * 64 + kq * 8; Sa[q] = *(const f32x4*)st; Sb[q] = *(const f32x4*)(st + 4); }
    __syncthreads();
#pragma unroll
    for (int q = 0; q < 8; ++q) {
        const int o = q * 64 + kq * 8;
        const f32x4 w0 = *(const LAS f32x4*)(sW + o), w1 = *(const LAS f32x4*)(sW + o + 4);
        const f32x4 q0 = *(const LAS f32x4*)(sKK + o), q1 = *(const LAS f32x4*)(sKK + o + 4);
        const f32x4 b0 = *(const LAS f32x4*)(sB + o), b1 = *(const LAS f32x4*)(sB + o + 4);
        const f32x4 k0 = *(const LAS f32x4*)(sK + o), k1 = *(const LAS f32x4*)(sK + o + 4);
        const f32x4 r0 = *(const LAS f32x4*)(sR + o), r1 = *(const LAS f32x4*)(sR + o + 4);
        const float vv = sV[q * 64 + v];
        f32x4 A = Sa[q], B = Sb[q];
        float sa = 0.f;
#pragma unroll
        for (int j = 0; j < 4; ++j) { sa += A[j] * q0[j]; sa += B[j] * q1[j]; }
        sa = -red8(sa);
        float y = 0.f;
#pragma unroll
        for (int j = 0; j < 4; ++j) {
            A[j] = A[j] * w0[j] + sa * b0[j] + vv * k0[j];
            B[j] = B[j] * w1[j] + sa * b1[j] + vv * k1[j];
            y += A[j] * r0[j]; y += B[j] * r1[j];
        }
        y = red8(y);
        if (kq == 0) sY[q * 64 + v] = y;
        float* so = p.out + O_WKS + (size_t)(j0 + q) * HD * HD + v * 64 + kq * 8;
        __builtin_nontemporal_store(A, (f32x4*)so); __builtin_nontemporal_store(B, (f32x4*)(so + 4));
    }
    __syncthreads();
    {
        const int o = wid * 64 + lane;
        const float y = sY[o];
        const float mu = wave_sum(y) * (1.f / 64.f); const float d = y - mu; const float var = wave_sum(d * d) * (1.f / 64.f);
        const float yn = d * (1.f / sqrtf(var + GN_EPS)) * gng + gnb;
        const float bonus = wave_sum(sR[o] * sK[o] * rk_w) * sV[o];
        const float g = DAG[(size_t)roww * 3072 + 2048 + ch];
        OMIX[(size_t)roww * D + ch] = f2bf((yn + bonus) * g * beta);
    }
    __syncthreads();
}

__device__ __forceinline__ void conv_item(const Params& p, LAS unsigned char* lds, int it) {
    const int tid = threadIdx.x, lane = tid & 63, wid = tid >> 6;
    const int c = 2 * tid;
    const float* U = (const float*)(p.ws + WS_U); bf16_t* OMIX = (bf16_t*)(p.ws + WS_OMIX);
    const bool samp = it >= 1024;
    const int b = it >> 8, t0 = (it & 255) * 8, s = it - 1024;
    const int row0 = samp ? MP + s : b * SEQ + t0;
    const int ntok = samp ? 1 : 8;
    f32x2 w[CW];
#pragma unroll
    for (int j = 0; j < CW; ++j) w[j] = *(const f32x2*)(p.in[I_CVW] + (size_t)j * DC + c);
    const f32x2 bias = *(const f32x2*)(p.in[I_CVB] + c);
    f32x2 acc[8];
#pragma unroll
    for (int i = 0; i < 8; ++i) acc[i] = bias;
#pragma unroll
    for (int q = 0; q < 38; ++q) {
        f32x2 u = (f32x2){0.f, 0.f};
        if (samp) { if (q < 30) u = *(const f32x2*)(p.in[I_SCV] + (size_t)(s * 30 + q) * DC + c); else if (q == 30) u = *(const f32x2*)(U + (size_t)(MP + s) * DC + c); }
        else { const int t = t0 - 30 + q; if (t >= 0) u = *(const f32x2*)(U + (size_t)(b * SEQ + t) * DC + c); }
#pragma unroll
        for (int i = 0; i < 8; ++i) { const int j = q - i; if (j >= 0 && j < CW) acc[i] += w[j] * u; }
    }
    LAS float* sC = (LAS float*)lds;
#pragma unroll
    for (int i = 0; i < 8; ++i) *(LAS f32x2*)(sC + i * DC + c) = acc[i];
    __syncthreads();
    if (wid < ntok) {
        const LAS f32x4* cr = (const LAS f32x4*)(sC + wid * DC) + lane;
        f32x4 v[4]; float sm = 0.f;
#pragma unroll
        for (int j = 0; j < 4; ++j) { v[j] = cr[64 * j]; sm += (v[j][0] + v[j][1]) + (v[j][2] + v[j][3]); }
        const float mean = wave_sum(sm) * (1.f / DC); float s2 = 0.f;
#pragma unroll
        for (int j = 0; j < 4; ++j) { v[j] = v[j] - mean; s2 += (v[j][0] * v[j][0] + v[j][1] * v[j][1]) + (v[j][2] * v[j][2] + v[j][3] * v[j][3]); }
        const float rstd = 1.f / sqrtf(wave_sum(s2) * (1.f / DC) + LN_EPS);
        bf16_t* orow = OMIX + (size_t)(row0 + wid) * D + DR;
#pragma unroll
        for (int j = 0; j < 4; ++j) {
            const f32x4 gv = ((const f32x4*)p.in[I_CLG])[64 * j + lane], bv = ((const f32x4*)p.in[I_CLB])[64 * j + lane], be = ((const f32x4*)p.in[I_BC])[64 * j + lane];
            f32x4 y = v[j] * rstd * gv + bv;
#pragma unroll
            for (int e = 0; e < 4; ++e) y[e] = y[e] / (1.f + expf(-y[e])) * be[e];
            ((u32x2*)orow)[64 * j + lane] = (u32x2){cvt_pk_bf16(y[0], y[1]), cvt_pk_bf16(y[2], y[3])};
        }
    }
    __syncthreads();
}
constexpr int SBUF = 6 * TC * 64;
struct ProdRegs { float c[8][3], q0[3], w[8], a[8]; };
__device__ __forceinline__ void prod_load(const Params& p, ProdRegs& R, int row0, int h, int pw, int lane) {
    const float* DAG = (const float*)(p.ws + WS_RB);
    const int ch = h * 64 + lane;
#pragma unroll
    for (int i = 0; i < 8; ++i) {
        const int s = pw * 8 + i;
        const float* dag = DAG + (size_t)(row0 + s) * 3072;
        load_rkv_cur(p, row0 + s, ch, R.c[i]);
        R.w[i] = dag[ch]; R.a[i] = dag[1024 + ch];
    }
    load_rkv_prev(p, row0 + pw * 8, ch, R.q0);
}
__device__ __forceinline__ void prod_store(const ProdRegs& R, LAS float* buf, int row0, int pw, int lane, float kk_w, float ka_w, float mu_r, float mu_k, float mu_v) {
#pragma unroll
    for (int i = 0; i < 8; ++i) {
        const int s = pw * 8 + i;
        const bool zp = (i == 0) && (((row0 + s) & (SEQ - 1)) == 0);
        const float qr = i ? R.c[i ? i - 1 : 0][0] : R.q0[0], qk = i ? R.c[i ? i - 1 : 0][1] : R.q0[1], qv = i ? R.c[i ? i - 1 : 0][2] : R.q0[2];
        const float r = shift_mix(R.c[i][0], qr, mu_r, zp), k = shift_mix(R.c[i][1], qk, mu_k, zp), vv = shift_mix(R.c[i][2], qv, mu_v, zp);
        const float kr = k * kk_w; const float n2 = wave_sum(kr * kr); const float kk = kr * __builtin_amdgcn_rsqf(fmaxf(n2, 1e-24f));
        const float kp = k * (1.f + (R.a[i] - 1.f) * ka_w);
        const int o = s * 64 + lane;
        buf[o] = r; buf[TC * 64 + o] = kp; buf[2 * TC * 64 + o] = vv; buf[3 * TC * 64 + o] = R.w[i]; buf[4 * TC * 64 + o] = kk; buf[5 * TC * 64 + o] = kk * R.a[i];
    }
}
struct StepRegs { f32x4 r4, k4, w4, q4, b4; float vv; };
__device__ __forceinline__ void step_load(StepRegs& T, const LAS float* pb, const LAS float* pv, int s) {
    T.r4 = *(const LAS f32x4*)(pb + s * 64); T.k4 = *(const LAS f32x4*)(pb + TC * 64 + s * 64); T.w4 = *(const LAS f32x4*)(pb + 3 * TC * 64 + s * 64);
    T.q4 = *(const LAS f32x4*)(pb + 4 * TC * 64 + s * 64); T.b4 = *(const LAS f32x4*)(pb + 5 * TC * 64 + s * 64); T.vv = pv[s * 64];
}
__device__ __forceinline__ f32x2 lo2(const f32x4& a) { return __builtin_shufflevector(a, a, 0, 1); }
__device__ __forceinline__ f32x2 hi2(const f32x4& a) { return __builtin_shufflevector(a, a, 2, 3); }
__device__ __forceinline__ void red16x2(float& a, float& b) {
    a += dppf<0xB1>(a); b += dppf<0xB1>(b); a += dppf<0x4E>(a); b += dppf<0x4E>(b);
    a += dppf<0x141>(a); b += dppf<0x141>(b); a += dppf<0x140>(a); b += dppf<0x140>(b);
}
template <bool STORE>
__device__ __forceinline__ void step_compute(const StepRegs& T, const f32x4& rprev, f32x2& S01, f32x2& S23, float* yprev) {
    const f32x2 vv2 = (f32x2){T.vv, T.vv};
    const f32x2 t01 = S01 * lo2(T.w4) + vv2 * lo2(T.k4), t23 = S23 * hi2(T.w4) + vv2 * hi2(T.k4);
    const f32x2 dv = S23 * hi2(T.q4) + S01 * lo2(T.q4);
    const f32x2 ev = S23 * hi2(rprev) + S01 * lo2(rprev);
    float d = dv[0] + dv[1], e = ev[0] + ev[1];
    red16x2(d, e);
    if (STORE) *yprev = e;
    const f32x2 d2 = (f32x2){d, d};
    S01 = t01 - d2 * lo2(T.b4); S23 = t23 - d2 * hi2(T.b4);
}
__device__ __forceinline__ void scan_consume(const LAS float* buf, f32x2& S01, f32x2& S23, int v, int kq, float* Yp) {
    const LAS float* pb = buf + kq * 4; const LAS float* pv = buf + 2 * TC * 64 + v;
    StepRegs A, B;
    step_load(A, pb, pv, 0);
    step_load(B, pb, pv, 1);
    step_compute<false>(A, A.r4, S01, S23, Yp);
#pragma unroll
    for (int s = 1; s < TC; s += 2) {
        const f32x4 rA = A.r4;
        if (s + 1 < TC) step_load(A, pb, pv, s + 1);
        step_compute<true>(B, rA, S01, S23, Yp + (size_t)(s - 1) * 1024);
        if (s + 1 < TC) {
            const f32x4 rB = B.r4;
            if (s + 2 < TC) step_load(B, pb, pv, s + 2);
            step_compute<true>(A, rB, S01, S23, Yp + (size_t)s * 1024);
        }
    }
    { const f32x2 ev = S23 * hi2(B.r4) + S01 * lo2(B.r4); Yp[(size_t)(TC - 1) * 1024] = red16(ev[0] + ev[1]); }
}
__device__ __forceinline__ void phase_scan(const Params& p, LAS unsigned char* lds, int G, int bid) {
    const int tid = threadIdx.x, lane = tid & 63, wid = __builtin_amdgcn_readfirstlane(tid >> 6);
    LAS float* buf0 = (LAS float*)lds; LAS float* buf1 = buf0 + SBUF;
    float* Y = (float*)(p.ws + WS_Y);
    constexpr int NCH = SEQ / TC;
    for (int item = bid; item < NB * NH * 4; item += G) {
        const int bh = item >> 2, qd = item & 3, b = bh >> 4, h = bh & 15, row0 = b * SEQ;
        const int ch = h * 64 + lane;
        const float kk_w = p.in[I_KK][ch], ka_w = p.in[I_KA][ch], mu_r = p.in[I_MU][ch], mu_k = p.in[I_MU][1024 + ch], mu_v = p.in[I_MU][2048 + ch];
        f32x2 S01 = (f32x2){0.f, 0.f}, S23 = (f32x2){0.f, 0.f};
        const int v = qd * 16 + (wid & 3) * 4 + (lane >> 4), kq = lane & 15;
        ProdRegs R;
        if (wid >= 4) { prod_load(p, R, row0, h, wid - 4, lane); prod_store(R, buf0, row0, wid - 4, lane, kk_w, ka_w, mu_r, mu_k, mu_v); prod_load(p, R, row0 + TC, h, wid - 4, lane); }
        asm volatile("s_waitcnt lgkmcnt(0)" ::: "memory"); __builtin_amdgcn_s_barrier(); asm volatile("" ::: "memory");
#pragma unroll 1
        for (int c = 0; c < NCH; ++c) {
            LAS float* cb = (c & 1) ? buf1 : buf0; LAS float* nb = (c & 1) ? buf0 : buf1;
            if (wid < 4) scan_consume(cb, S01, S23, v, kq, Y + (size_t)(row0 + c * TC) * 1024 + h * 64 + v);
            else {
                if (c + 1 < NCH) prod_store(R, nb, row0 + (c + 1) * TC, wid - 4, lane, kk_w, ka_w, mu_r, mu_k, mu_v);
                if (c + 2 < NCH) prod_load(p, R, row0 + (c + 2) * TC, h, wid - 4, lane);
            }
            asm volatile("s_waitcnt lgkmcnt(0)" ::: "memory"); __builtin_amdgcn_s_barrier(); asm volatile("" ::: "memory");
        }
        if (wid < 4) *(f32x4*)(p.out + O_WKP + (size_t)bh * HD * HD + v * 64 + kq * 4) = (f32x4){S01[0], S01[1], S23[0], S23[1]};
    }
}
__device__ __forceinline__ void phase_mix2(const Params& p, LAS unsigned char* lds, int G, int bid) {
    const int tid = threadIdx.x, lane = tid & 63, wid = tid >> 6;
    {
        const float* DAG = (const float*)(p.ws + WS_RB); const float* Y = (const float*)(p.ws + WS_Y); bf16_t* OMIX = (bf16_t*)(p.ws + WS_OMIX);
        const int gw = bid * 8 + wid, NGW = G * 8;
        const int h = gw & 15, ch = h * 64 + lane;
        const float ka_w = p.in[I_KA][ch], rk_w = p.in[I_RK][ch], gng = p.in[I_GNG][ch], gnb = p.in[I_GNB][ch], beta = p.in[I_BR][ch];
        const float mu_r = p.in[I_MU][ch], mu_k = p.in[I_MU][1024 + ch], mu_v = p.in[I_MU][2048 + ch];
        const int rstep = NGW >> 4;
        for (int grp = gw >> 4; grp < MP / 4; grp += rstep) {
            const int rb = grp * 4;
            float y[4], cc[4][3], q0[3], a[4], g[4];
#pragma unroll
            for (int u = 0; u < 4; ++u) {
                const int row = rb + u; const float* dag = DAG + (size_t)row * 3072;
                load_rkv_cur(p, row, ch, cc[u]); y[u] = Y[(size_t)row * 1024 + ch]; a[u] = dag[1024 + ch]; g[u] = dag[2048 + ch];
            }
            load_rkv_prev(p, rb, ch, q0);
#pragma unroll
            for (int u = 0; u < 4; ++u) {
                const int row = rb + u;
                const bool zp = (u == 0) && ((row & (SEQ - 1)) == 0);
                const float qr = u ? cc[u ? u - 1 : 0][0] : q0[0], qk = u ? cc[u ? u - 1 : 0][1] : q0[1], qv = u ? cc[u ? u - 1 : 0][2] : q0[2];
                const float r = shift_mix(cc[u][0], qr, mu_r, zp), k = shift_mix(cc[u][1], qk, mu_k, zp), vv = shift_mix(cc[u][2], qv, mu_v, zp);
                const float kp = k * (1.f + (a[u] - 1.f) * ka_w);
                const float mu = wave_sum(y[u]) * (1.f / 64.f); const float d = y[u] - mu; const float var = wave_sum(d * d) * (1.f / 64.f);
                const float yn = d * (1.f / sqrtf(var + GN_EPS)) * gng + gnb;
                const float bonus = wave_sum(r * kp * rk_w) * vv;
                OMIX[(size_t)row * D + ch] = f2bf((yn + bonus) * g[u] * beta);
            }
        }
    }
    constexpr int NCONV = 1024 + MS, NSAMP8 = MS * NH / 8;
    for (int it = bid; it < NCONV + NSAMP8; it += G) {
        if (it < NCONV) conv_item(p, lds, it);
        else rwkv_sample8(p, lds, (it - NCONV) * 8);
    }
}

__device__ __forceinline__ void samp_attn_item(const Params& p, LAS unsigned char* lds, int it) {
    const int tid = threadIdx.x, lane = tid & 63, wid = tid >> 6;
    const int s = it >> 2, h = it & 3;
    bf16_t* OA = (bf16_t*)(p.ws + WS_OA) + (size_t)(MP + s) * D + h * MHD;
    LAS float* sS = (LAS float*)lds;
    LAS float* sO = sS + 256;
    float q[8];
    { const float* PART = (const float*)(p.ws + WS_PART) + (size_t)s * D + h * MHD;
      f32x4 a = (f32x4){0.f, 0.f, 0.f, 0.f}, b = a;
#pragma unroll
      for (int sl = 0; sl < 8; ++sl) { a += *(const f32x4*)(PART + (size_t)sl * 128 * D + lane * 4); b += *(const f32x4*)(PART + (size_t)sl * 128 * D + 256 + lane * 4); }
#pragma unroll
      for (int j = 0; j < 4; ++j) { q[j] = a[j] * QSCALE; q[4 + j] = b[j] * QSCALE; } }
    const float* Kc = p.in[I_CK] + ((size_t)s * NMEM * NMH + h) * MHD;
    const float* Vc = p.in[I_CV] + ((size_t)s * NMEM * NMH + h) * MHD;
#pragma unroll 1
    for (int kb = 0; kb < 32; kb += 4) {
        f32x4 ka[4], kb4[4];
#pragma unroll
        for (int u = 0; u < 4; ++u) { const float* kr = Kc + (size_t)(wid * 32 + kb + u) * D; ka[u] = __builtin_nontemporal_load((const f32x4*)(kr + lane * 4)); kb4[u] = __builtin_nontemporal_load((const f32x4*)(kr + 256 + lane * 4)); }
#pragma unroll
        for (int u = 0; u < 4; ++u) {
            float d = ka[u][0] * q[0] + ka[u][1] * q[1] + ka[u][2] * q[2] + ka[u][3] * q[3] + kb4[u][0] * q[4] + kb4[u][1] * q[5] + kb4[u][2] * q[6] + kb4[u][3] * q[7];
            d = wave_sum(d);
            if (lane == 0) sS[wid * 32 + kb + u] = d;
        }
    }
    __syncthreads();
    {
        const float s0 = sS[lane], s1 = sS[lane + 64], s2 = sS[lane + 128], s3 = sS[lane + 192];
        const float mx = wave_max(fmaxf(fmaxf(s0, s1), fmaxf(s2, s3)));
        const float e0 = __expf(s0 - mx), e1 = __expf(s1 - mx), e2 = __expf(s2 - mx), e3 = __expf(s3 - mx);
        const float inv = 1.f / wave_sum((e0 + e1) + (e2 + e3));
        __syncthreads();
        if (wid == 0) { sS[lane] = e0 * inv; sS[lane + 64] = e1 * inv; sS[lane + 128] = e2 * inv; sS[lane + 192] = e3 * inv; }
    }
    __syncthreads();
    {
        const int g = tid >> 7, d4 = tid & 127;
        f32x4 o = (f32x4){0.f, 0.f, 0.f, 0.f};
#pragma unroll 1
        for (int kb = 0; kb < 64; kb += 8) {
            f32x4 vv[8];
#pragma unroll
            for (int u = 0; u < 8; ++u) vv[u] = __builtin_nontemporal_load((const f32x4*)(Vc + (size_t)(g * 64 + kb + u) * D + d4 * 4));
#pragma unroll
            for (int u = 0; u < 8; ++u) o += vv[u] * sS[g * 64 + kb + u];
        }
        *(LAS f32x4*)(sO + g * 512 + d4 * 4) = o;
    }
    __syncthreads();
    if (tid < 128) {
        const f32x4 o = (*(const LAS f32x4*)(sO + tid * 4) + *(const LAS f32x4*)(sO + 512 + tid * 4)) + (*(const LAS f32x4*)(sO + 1024 + tid * 4) + *(const LAS f32x4*)(sO + 1536 + tid * 4));
        *(u32x2*)(OA + tid * 4) = (u32x2){cvt_pk_bf16(o[0], o[1]), cvt_pk_bf16(o[2], o[3])};
    }
    __syncthreads();
}

#define XB_TMO      128
#define XB_XCNT(j)  (256  + 64 * (j))
#define XB_XSUB(j)  (1280 + 64 * (j))
#define XB_XGEN(j)  (2304 + 64 * (j))
#define XB_TOP      3328
#define XB_TOPGEN   3392
#define XCD_BAR_WORDS 3456
#define XB_SPIN_CAP (1u << 18)
__device__ __forceinline__ unsigned xb_ld(unsigned* p)              { return __hip_atomic_load(p, __ATOMIC_RELAXED, __HIP_MEMORY_SCOPE_AGENT); }
__device__ __forceinline__ unsigned xb_add(unsigned* p, unsigned v) { return __hip_atomic_fetch_add(p, v, __ATOMIC_RELAXED, __HIP_MEMORY_SCOPE_AGENT); }
__device__ __forceinline__ unsigned xb_xcc_id() { return (unsigned)__builtin_amdgcn_s_getreg((3 << 11) | 20) & 0xFu; }
#define XB_SPIN(cond, bar) do { unsigned _sp = 0; while (cond) { __builtin_amdgcn_s_sleep(1); \
    if ((++_sp & 255u) == 0u) { if (xb_ld(&(bar)[XB_TMO])) break; if (_sp > XB_SPIN_CAP) { atomicAdd(&(bar)[XB_TMO], 1u); break; } } } } while (0)
struct XcdBarrier { unsigned* bar; unsigned x; volatile LAS unsigned* st; };
__device__ __forceinline__ XcdBarrier xcd_barrier_post(unsigned* bar, volatile LAS unsigned* st) {
    XcdBarrier b; b.bar = bar; b.x = xb_xcc_id(); b.st = st;
    if (threadIdx.x == 0) (void)xb_add(&bar[XB_XCNT(b.x)], 1u);
    return b;
}
__device__ __forceinline__ void xcd_barrier_complete(unsigned* bar, unsigned x, unsigned& nloc, unsigned& nx) {
    const unsigned G = gridDim.x * gridDim.y * gridDim.z;
    unsigned sum, cnt, mine, sp = 0u;
    for (;;) {
        sum = 0u; cnt = 0u; mine = 0u;
#pragma unroll
        for (unsigned j = 0; j < 16; ++j) { const unsigned c = xb_ld(&bar[XB_XCNT(j)]); sum += c; cnt += (c > 0u) ? 1u : 0u; mine = (j == x) ? c : mine; }
        if (sum == G) break;
        __builtin_amdgcn_s_sleep(1);
        if ((++sp & 255u) == 0u) { if (xb_ld(&bar[XB_TMO])) break; if (sp > XB_SPIN_CAP) { atomicAdd(&bar[XB_TMO], 1u); break; } }
    }
    nloc = mine > 0u ? mine : 1u; nx = cnt > 0u ? cnt : 1u;
}
__device__ __forceinline__ void xcd_barrier(const XcdBarrier& b) {
    asm volatile("s_waitcnt vmcnt(0)" ::: "memory");
    __syncthreads();
    if (threadIdx.x == 0) {
        unsigned* bar = b.bar;
        __builtin_amdgcn_s_waitcnt(0);
        unsigned nloc = b.st[0], nx = b.st[1];
        if (nloc == 0u) { xcd_barrier_complete(bar, b.x, nloc, nx); b.st[0] = nloc; b.st[1] = nx; }
        const unsigned old = xb_add(&bar[XB_XSUB(b.x)], 1u);
        const unsigned gen = old / nloc;
        if (old + 1u == (gen + 1u) * nloc) {
            __builtin_amdgcn_fence(__ATOMIC_RELEASE, "agent");
            asm volatile("s_waitcnt vmcnt(0)" ::: "memory");
            const unsigned og = xb_add(&bar[XB_TOP], 1u);
            const unsigned tg = og / nx;
            if (og + 1u == (tg + 1u) * nx) xb_add(&bar[XB_TOPGEN], 1u);
            else XB_SPIN(xb_ld(&bar[XB_TOPGEN]) == tg, bar);
            __builtin_amdgcn_fence(__ATOMIC_ACQUIRE, "agent");
            xb_add(&bar[XB_XGEN(b.x)], 1u);
            asm volatile("s_waitcnt vmcnt(0)" ::: "memory");
        } else {
            XB_SPIN(xb_ld(&bar[XB_XGEN(b.x)]) == gen, bar);
            __builtin_amdgcn_fence(__ATOMIC_ACQUIRE, "agent");
            asm volatile("s_waitcnt vmcnt(0)" ::: "memory");
        }
    }
    __syncthreads();
}

__global__ void __launch_bounds__(512, 2) fwd_megakernel(Params p) {
    extern __shared__ __attribute__((aligned(16))) unsigned char lds_raw[];
    LAS unsigned char* lds = (LAS unsigned char*)lds_raw;
    cg::grid_group grid = cg::this_grid();
    const int G = gridDim.x, bid = blockIdx.x;
    unsigned char* ws = p.ws;
    const int lo = p.ph_lo, hi = p.ph_hi;
#define IN(k) (lo <= (k) && (k) < hi)
    volatile LAS unsigned* bst = (volatile LAS unsigned*)(lds + 131072);
    if (threadIdx.x < 2) bst[threadIdx.x] = 0u;
    __syncthreads();
    XcdBarrier xbar = xcd_barrier_post((unsigned*)(ws + WS_CTL), bst);
    if (p.ph_hi < 0) grid.sync();
#define SEAM(k) do { if (IN(k) && IN((k) + 1)) xcd_barrier(xbar); } while (0)
#define EXTRA_SYNC() xcd_barrier(xbar)
    bf16_t* XB = (bf16_t*)(ws + WS_XB); bf16_t* Z = (bf16_t*)(ws + WS_Z); float* XF = (float*)(ws + WS_XF);
    bf16_t* Hb = (bf16_t*)(ws + WS_RB);

    float* PART = (float*)(ws + WS_PART);
    if (IN(0)) { for (int _r = 0; _r <= ((DUPMASK >> 0) & 1); ++_r) { phase_prep(p, lds, G, bid);  if (_r < ((DUPMASK >> 0) & 1)) EXTRA_SYNC(); } } SEAM(0);
    if (IN(1)) { for (int _r = 0; _r <= ((DUPMASK >> 1) & 1); ++_r) {
        { SchedPlain S; S.init(XB, ws + WS_W13A, D, D, 33, 44, G, bid); EpiGluH E{Hb}; gemm_phase(lds, D, D, D, S, E); }
        { SchedPlain S; S.init(ws + WS_MEMB, ws + WS_WMK, D, D, 4, 16, G, G - 1 - bid); EpiMemKV E{p.out + O_MKP, p.out + O_MVP, (bf16_t*)(ws + WS_KB), (bf16_t*)(ws + WS_VT)}; gemm_phase(lds, D, D, D, S, E); }
     if (_r < ((DUPMASK >> 1) & 1)) EXTRA_SYNC(); } } SEAM(1);
    if (IN(2)) { for (int _r = 0; _r <= ((DUPMASK >> 2) & 1); ++_r) {
        { SchedPlain S; S.init(Hb, ws + WS_W2A, FF, FF, 32, 8, G, bid); EpiResidB E{Z, XB, 0.5f}; gemm_phase(lds, FF, FF, FF, S, E); }
        { SchedPieces S{(const char*)Hb, (const char*)(ws + WS_W2A), FF, FF, 8 * 22, G, bid}; EpiPart E{PART}; gemm_phase(lds, FF, FF, 256, S, E); }
     if (_r < ((DUPMASK >> 2) & 1)) EXTRA_SYNC(); } } SEAM(2);
    if (IN(3)) { for (int _r = 0; _r <= ((DUPMASK >> 3) & 1); ++_r) { phase_ln(lds, Z, p.in[I_LN1G], p.in[I_LN1B], nullptr, XB, G, bid, PART, 22, p.in[I_XS], nullptr, 0.5f);  if (_r < ((DUPMASK >> 3) & 1)) EXTRA_SYNC(); } } SEAM(3);
    if (IN(4)) { for (int _r = 0; _r <= ((DUPMASK >> 4) & 1); ++_r) {
        SchedPlain S; S.init(XB, ws + WS_WIN, D, D, 33, 22, G, bid); EpiWin E{(float*)(ws + WS_RA), (float*)(ws + WS_U)}; gemm_phase(lds, D, D, D, S, E);
     if (_r < ((DUPMASK >> 4) & 1)) EXTRA_SYNC(); } } SEAM(4);
    if (IN(5)) { for (int _r = 0; _r <= ((DUPMASK >> 5) & 1); ++_r) { phase_mixpre(p, G, bid);  if (_r < ((DUPMASK >> 5) & 1)) EXTRA_SYNC(); } } SEAM(5);
    if (IN(6)) { for (int _r = 0; _r <= ((DUPMASK >> 6) & 1); ++_r) {
        SchedPlain S; S.init(ws + WS_LA, ws + WS_WLORA, LK, LK, 33, 12, G, bid); EpiLora E{(float*)(ws + WS_RB), p.in[I_W0], p.in[I_A0]}; gemm_phase(lds, LK, LK, LK, S, E);
     if (_r < ((DUPMASK >> 6) & 1)) EXTRA_SYNC(); } } SEAM(6);
    if (IN(7)) { for (int _r = 0; _r <= ((DUPMASK >> 7) & 1); ++_r) { phase_scan(p, lds, G, bid);  if (_r < ((DUPMASK >> 7) & 1)) EXTRA_SYNC(); } } SEAM(7);
    if (IN(8)) { for (int _r = 0; _r <= ((DUPMASK >> 8) & 1); ++_r) { phase_mix2(p, lds, G, bid);  if (_r < ((DUPMASK >> 8) & 1)) EXTRA_SYNC(); } } SEAM(8);
    if (IN(9)) { for (int _r = 0; _r <= ((DUPMASK >> 9) & 1); ++_r) {
        { SchedPlain S; S.init(ws + WS_OMIX, ws + WS_WOUT, D, D, 32, 8, G, bid); EpiResidB E{Z, XB, 1.0f}; gemm_phase(lds, D, D, D, S, E); }
        { SchedPieces S{(const char*)(ws + WS_OMIX), (const char*)(ws + WS_WOUT), D, D, 8 * 8, G, bid}; EpiPart E{PART}; gemm_phase(lds, D, D, 256, S, E); }
     if (_r < ((DUPMASK >> 9) & 1)) EXTRA_SYNC(); } } SEAM(9);
    if (IN(10)) { for (int _r = 0; _r <= ((DUPMASK >> 10) & 1); ++_r) { phase_ln(lds, Z, p.in[I_LN2G], p.in[I_LN2B], nullptr, XB, G, bid, PART, 8, nullptr, XB + (size_t)MP * D, 1.0f);  if (_r < ((DUPMASK >> 10) & 1)) EXTRA_SYNC(); } } SEAM(10);
    if (IN(11)) { for (int _r = 0; _r <= ((DUPMASK >> 11) & 1); ++_r) {
        { SchedPlain S; S.init(XB, ws + WS_WMQ, D, D, 32, 8, G, bid); EpiBf16 E{(bf16_t*)(ws + WS_Q), D, QSCALE, MP}; gemm_phase(lds, D, D, D, S, E); }
        { SchedPieces S{(const char*)XB, (const char*)(ws + WS_WMQ), D, D, 8 * 8, G, bid}; EpiPart E{PART}; gemm_phase(lds, D, D, 256, S, E); }
     if (_r < ((DUPMASK >> 11) & 1)) EXTRA_SYNC(); } } SEAM(11);
    if (IN(12)) { for (int _r = 0; _r <= ((DUPMASK >> 12) & 1); ++_r) {
        { SchedScores S{(const char*)(ws + WS_Q), (const char*)(ws + WS_KB), G, bid}; EpiSoftmax E{(bf16_t*)(ws + WS_P)}; gemm_phase(lds, D, D, MHD, S, E); }
        for (int it = bid; it < MS * NMH; it += G) samp_attn_item(p, lds, it);
     if (_r < ((DUPMASK >> 12) & 1)) EXTRA_SYNC(); } } SEAM(12);
    if (IN(13)) { for (int _r = 0; _r <= ((DUPMASK >> 13) & 1); ++_r) {
        SchedPV S{(const char*)(ws + WS_P), (const char*)(ws + WS_VT), G, bid}; EpiBf16 E{(bf16_t*)(ws + WS_OA), D, 1.0f, MP}; gemm_phase(lds, 1024, NMEM, NMEM, S, E);
     if (_r < ((DUPMASK >> 13) & 1)) EXTRA_SYNC(); } } SEAM(13);
    if (IN(14)) { for (int _r = 0; _r <= ((DUPMASK >> 14) & 1); ++_r) {
        { SchedPlain S; S.init(ws + WS_OA, ws + WS_WMO, D, D, 32, 8, G, bid); EpiResidB E{Z, XB, 1.0f}; gemm_phase(lds, D, D, D, S, E); }
        { SchedPieces S{(const char*)(ws + WS_OA), (const char*)(ws + WS_WMO), D, D, 8 * 8, G, bid}; EpiPart E{PART}; gemm_phase(lds, D, D, 256, S, E); }
     if (_r < ((DUPMASK >> 14) & 1)) EXTRA_SYNC(); } } SEAM(14);
    if (IN(15)) { for (int _r = 0; _r <= ((DUPMASK >> 15) & 1); ++_r) { phase_ln(lds, Z, p.in[I_LN3G], p.in[I_LN3B], nullptr, XB, G, bid, PART, 8, nullptr, XB + (size_t)MP * D, 1.0f);  if (_r < ((DUPMASK >> 15) & 1)) EXTRA_SYNC(); } } SEAM(15);
    if (IN(16)) { for (int _r = 0; _r <= ((DUPMASK >> 16) & 1); ++_r) {
        SchedPlain S; S.init(XB, ws + WS_W13B, D, D, 33, 44, G, bid); EpiGluH E{Hb}; gemm_phase(lds, D, D, D, S, E);
     if (_r < ((DUPMASK >> 16) & 1)) EXTRA_SYNC(); } } SEAM(16);
    if (IN(17)) { for (int _r = 0; _r <= ((DUPMASK >> 17) & 1); ++_r) {
        { SchedPlain S; S.init(Hb, ws + WS_W2B, FF, FF, 32, 8, G, bid); EpiResidB E{Z, XB, 0.5f}; gemm_phase(lds, FF, FF, FF, S, E); }
        { SchedPieces S{(const char*)Hb, (const char*)(ws + WS_W2B), FF, FF, 8 * 22, G, bid}; EpiPart E{PART}; gemm_phase(lds, FF, FF, 256, S, E); }
     if (_r < ((DUPMASK >> 17) & 1)) EXTRA_SYNC(); } } SEAM(17);
    if (IN(18)) for (int _r = 0; _r <= ((DUPMASK >> 18) & 1); ++_r) { if (_r) EXTRA_SYNC(); phase_ln(lds, Z, p.in[I_LN4G], p.in[I_LN4B], p.out + O_Y, nullptr, G, bid, PART, 22, nullptr, XB + (size_t)MP * D, 0.5f); }
#undef IN
#undef SEAM
}

extern "C" void kernel_launch(void* const* d_in, const int* in_sizes, int n_in, void* d_out, int out_size, void* d_ws, size_t ws_size, hipStream_t stream) {
    static int grid = 0;
    if (grid == 0) {
        if (n_in != N_IN || (size_t)out_size != O_END || ws_size < WS_END) { fprintf(stderr, "kernel_launch: unexpected shapes: n_in %d out %d ws %zu (need %zu)\n", n_in, out_size, ws_size, (size_t)WS_END); grid = -1; return; }
        int dev = 0, cus = 0, per_cu = 0;
        if (hipGetDevice(&dev) != hipSuccess || hipDeviceGetAttribute(&cus, hipDeviceAttributeMultiprocessorCount, dev) != hipSuccess) { fprintf(stderr, "kernel_launch: device query failed\n"); grid = -1; return; }
        if (hipFuncSetAttribute((const void*)fwd_megakernel, hipFuncAttributeMaxDynamicSharedMemorySize, LDS_BYTES) != hipSuccess) { fprintf(stderr, "kernel_launch: hipFuncSetAttribute failed\n"); grid = -1; return; }
        if (hipOccupancyMaxActiveBlocksPerMultiprocessor(&per_cu, (const void*)fwd_megakernel, 512, LDS_BYTES) != hipSuccess || per_cu < 1) { fprintf(stderr, "kernel_launch: occupancy query gives %d\n", per_cu); (void)hipGetLastError(); per_cu = 1; }
        grid = cus * 1;
        if (grid < 128) { fprintf(stderr, "kernel_launch: grid %d too small\n", grid); grid = -1; return; }
    }
    if (grid < 0) return;
    Params p{};
    for (int i = 0; i < N_IN; ++i) p.in[i] = (const float*)d_in[i];
    p.out = (float*)d_out; p.ws = (unsigned char*)d_ws; p.ph_lo = 0; p.ph_hi = NPHASE;
    if (hipMemsetAsync((char*)d_ws + WS_CTL, 0, 16384, stream) != hipSuccess) { fprintf(stderr, "kernel_launch: memset of the barrier words failed\n"); return; }
    void* args[] = {&p};
    hipError_t e = hipLaunchCooperativeKernel((const void*)fwd_megakernel, dim3(grid), dim3(512), args, LDS_BYTES, stream);
    if (e != hipSuccess) fprintf(stderr, "cooperative launch failed: %s (grid %d)\n", hipGetErrorString(e), grid);
}
```

```cpp
#ifndef DUPMASK
#define DUPMASK 0
#endif
#include <hip/hip_runtime.h>
#include <hip/hip_cooperative_groups.h>
#include <cstdio>
#include <cstdint>
namespace cg = cooperative_groups;

#define LAS __attribute__((address_space(3)))
typedef unsigned short bf16_t;
typedef short bf16x8 __attribute__((ext_vector_type(8)));
typedef float f32x4 __attribute__((ext_vector_type(4)));
typedef float f32x2 __attribute__((ext_vector_type(2)));
typedef unsigned u32x4 __attribute__((ext_vector_type(4)));
typedef unsigned u32x2 __attribute__((ext_vector_type(2)));

constexpr int D = 2048, MP = 8192, MS = 128, M = MP + MS, MPAD = 8448, SEQ = 2048, NB = 4;
constexpr int FF = 5632, SC = 3360, DR = 1024, DC = 1024, NH = 16, HD = 64;
constexpr int NMEM = 256, NMH = 4, MHD = 512, CW = 31, LK = 384;
constexpr float ALPHA = 1.189207115002721f;
constexpr float LN_EPS = 1e-5f, GN_EPS = 64e-5f;
constexpr float QSCALE = 0.044194173824159216f;

enum { I_XP = 0, I_XS, I_MEM, I_SSH, I_SCV, I_SWKV, I_CK, I_CV, I_F1W1, I_F1W3, I_F1W2, I_LN1G, I_LN1B, I_WIN, I_MU, I_W0, I_W2D, I_A0, I_A2, I_G2,
       I_KK, I_KA, I_RK, I_GNG, I_GNB, I_CVW, I_CVB, I_CLG, I_CLB, I_BR, I_BC, I_WOUT, I_LN2G, I_LN2B, I_WMQ, I_WMK, I_WMV, I_WMO, I_LN3G, I_LN3B,
       I_F2W1, I_F2W3, I_F2W2, I_LN4G, I_LN4B, N_IN };
constexpr size_t O_Y = 0, O_SHP = (size_t)M * D, O_CVP = O_SHP + (size_t)NB * SC, O_WKP = O_CVP + (size_t)NB * 30 * DC, O_MKP = O_WKP + (size_t)NB * NH * HD * HD,
                 O_MVP = O_MKP + (size_t)NB * NMEM * D, O_SHS = O_MVP + (size_t)NB * NMEM * D, O_CVS = O_SHS + (size_t)MS * SC, O_WKS = O_CVS + (size_t)MS * 30 * DC,
                 O_END = O_WKS + (size_t)MS * NH * HD * HD;
constexpr size_t MiB = 1u << 20;
constexpr size_t WS_W13A = 0, WS_W2A = WS_W13A + 44 * MiB, WS_WIN = WS_W2A + 22 * MiB, WS_WOUT = WS_WIN + 22 * MiB, WS_WMQ = WS_WOUT + 8 * MiB, WS_WMK = WS_WMQ + 8 * MiB,
                 WS_WMV = WS_WMK + 8 * MiB, WS_WMO = WS_WMV + 8 * MiB, WS_W13B = WS_WMO + 8 * MiB, WS_W2B = WS_W13B + 44 * MiB, WS_WLORA = WS_W2B + 22 * MiB,
                 WS_XB = WS_WLORA + 3 * MiB,
                 WS_Z = WS_XB + 33 * MiB,
                 WS_XF = WS_Z + 65 * MiB,
                 WS_RA = WS_XF + 65 * MiB,
                 WS_RB = WS_RA + 107 * MiB,
                 WS_RKV = WS_RB + 98 * MiB,
                 WS_U = WS_RKV + 98 * MiB,
                 WS_LA = WS_U + 33 * MiB,
                 WS_OMIX = WS_LA + 7 * MiB,
                 WS_MEMB = WS_OMIX + 33 * MiB,
                 WS_KB = WS_MEMB + 4 * MiB,
                 WS_VT = WS_KB + 4 * MiB,
                 WS_PART = WS_VT + 4 * MiB,
                 WS_CTL = WS_PART + 23 * MiB,
                 WS_END = WS_CTL + 1 * MiB;
constexpr size_t WS_Y = WS_RKV;
constexpr size_t WS_Q = WS_RA, WS_P = WS_RA + 33 * MiB, WS_OA = WS_RA + 50 * MiB;

constexpr int LDS_BYTES = 131072 + 2048;
constexpr int NPHASE = 19;

struct Params { const float* in[N_IN]; float* out; unsigned char* ws; int ph_lo, ph_hi; };

__device__ __forceinline__ unsigned cvt_pk_bf16(float lo, float hi) { unsigned r; asm("v_cvt_pk_bf16_f32 %0, %1, %2" : "=v"(r) : "v"(lo), "v"(hi)); return r; }
__device__ __forceinline__ bf16_t f2bf(float f) { return (bf16_t)(cvt_pk_bf16(f, f) & 0xffffu); }
__device__ __forceinline__ float bf2f(bf16_t b) { return __builtin_bit_cast(float, (unsigned)b << 16); }
template <int C> __device__ __forceinline__ float dppf(float v) { return __builtin_bit_cast(float, __builtin_amdgcn_update_dpp(0, __builtin_bit_cast(int, v), C, 0xF, 0xF, true)); }
__device__ __forceinline__ float red8(float x) { x += dppf<0xB1>(x); x += dppf<0x4E>(x); x += dppf<0x141>(x); return x; }
__device__ __forceinline__ float red16(float x) { x += dppf<0xB1>(x); x += dppf<0x4E>(x); x += dppf<0x141>(x); x += dppf<0x140>(x); return x; }
__device__ __forceinline__ float swap16_sum(float x) { float a = x, b = x; asm volatile("s_nop 1\n\tv_permlane16_swap_b32 %0, %1" : "+v"(a), "+v"(b)); return a + b; }
__device__ __forceinline__ float swap32_sum(float x) { float a = x, b = x; asm volatile("s_nop 1\n\tv_permlane32_swap_b32 %0, %1" : "+v"(a), "+v"(b)); return a + b; }
__device__ __forceinline__ float wave_sum(float v) { return swap32_sum(swap16_sum(red16(v))); }
__device__ __forceinline__ float wave_max(float v) {
#pragma unroll
    for (int o = 1; o < 64; o <<= 1) v = fmaxf(v, __shfl_xor(v, o));
    return v;
}
__device__ __forceinline__ float sigmoid_f(float x) { return __builtin_amdgcn_rcpf(1.f + __expf(-x)); }
__device__ __forceinline__ float silu_f(float x) { return x * __builtin_amdgcn_rcpf(1.f + __expf(-x)); }

constexpr int BK = 64, HALF = 128, HTB = HALF * BK * 2;
__device__ __forceinline__ int lds_byte(int r, int c) { const int st = (r >> 4) * 2 + (c >> 5), rr = r & 15, cc = c & 31, ob = rr * 64 + cc * 2; return st * 1024 + (ob ^ (((ob >> 9) & 1) << 5)); }
__device__ __forceinline__ void stage_rc(int b, int& R, int& C) { const int st = b / 1024, sb = b % 1024, swz = sb ^ (((sb >> 9) & 1) << 5); R = (st >> 1) * 16 + swz / 64; C = (st & 1) * 32 + (swz % 64) / 2; }
__device__ __forceinline__ int perm32(int rho) { const int n = rho >> 4, i = rho & 15; return 8 * (i >> 2) + 4 * n + (i & 3); }

struct Unit { const char* A; const char* B; int r0, c0, tn; };
typedef f32x4 Acc[2][2][4][2];

struct SchedPlain {
    const char* A; const char* B; int lda, ldb, nM, nN, nwg, G, c;
    __device__ __forceinline__ void init(const void* A_, const void* B_, int lda_, int ldb_, int nM_, int nN_, int G_, int c_) { A = (const char*)A_; B = (const char*)B_; lda = lda_; ldb = ldb_; nM = nM_; nN = nN_; nwg = nM_ * nN_; G = G_; c = c_; }
    __device__ __forceinline__ bool next(int i, Unit& u) const {
        const long L = (long)i * G + c; if (L >= nwg) return false;
        int wgid = (int)L; { const int q = nwg / 8, r = nwg % 8, xcd = wgid % 8, off = wgid / 8; wgid = (xcd < r ? xcd * (q + 1) : r * (q + 1) + (xcd - r) * q) + off; }
        const int nig = 8 * nN, gid = wgid / nig, fm = gid * 8, gsz = (nM - fm) < 8 ? (nM - fm) : 8;
        const int pm = fm + ((wgid % nig) % gsz), pn = (wgid % nig) / gsz;
        u.A = A + (size_t)pm * 256 * lda * 2; u.B = B + (size_t)pn * 256 * ldb * 2; u.r0 = pm * 256; u.c0 = pn * 256; u.tn = pn; return true;
    }
};
struct SchedScores {
    const char* Q; const char* KB; int G, c;
    __device__ __forceinline__ bool next(int i, Unit& u) const {
        const long L = (long)i * G + c; if (L >= 128) return false;
        const int z = (int)L >> 3, pm = (int)L & 7, b = z >> 2, h = z & 3;
        u.A = Q + ((size_t)(b * SEQ + pm * 256) * D + h * MHD) * 2; u.B = KB + ((size_t)(b * NMEM) * D + h * MHD) * 2; u.r0 = b * SEQ + pm * 256; u.c0 = h * NMEM; u.tn = 0; return true;
    }
};
struct SchedPV {
    const char* P; const char* VT; int G, c;
    __device__ __forceinline__ bool next(int i, Unit& u) const {
        const long L = (long)i * G + c; if (L >= 256) return false;
        const int z = (int)L >> 4, pm = ((int)L & 15) >> 1, pn = (int)L & 1, b = z >> 2, h = z & 3;
        u.A = P + ((size_t)(b * SEQ + pm * 256) * 1024 + h * NMEM) * 2; u.B = VT + ((size_t)(b * D + h * MHD + pn * 256) * NMEM) * 2; u.r0 = b * SEQ + pm * 256; u.c0 = h * MHD + pn * 256; u.tn = pn; return true;
    }
};

struct SchedPieces {
    const char* A; const char* B; int lda, ldb, total, G, c;
    __device__ __forceinline__ bool next(int i, Unit& u) const {
        const long L = (long)i * G + c; if (L >= total) return false;
        const int pn = (int)L & 7, sl = (int)L >> 3;
        u.A = A + ((size_t)MP * lda + sl * 256) * 2; u.B = B + ((size_t)pn * 256 * ldb + sl * 256) * 2; u.r0 = MP; u.c0 = pn * 256; u.tn = sl; return true;
    }
};

template <class Epi, class Sched>
__device__ __forceinline__ void gemm_phase(LAS unsigned char* lds, const int lda, const int ldb, const int K, const Sched& S, const Epi& E) {
    const int tid = threadIdx.x, wid = __builtin_amdgcn_readfirstlane(tid >> 6), lane = tid & 63, wr = wid >> 2, wc = wid & 3, fr = lane & 15, fq = lane >> 4;
    const int nt = K / BK;
    unsigned voffA[2], voffB[2];
#pragma unroll
    for (int i = 0; i < 2; ++i) { int R, C; stage_rc(tid * 16 + i * 8192, R, C); const int Rb = (R & ~31) + perm32(R & 31);
        voffA[i] = (unsigned)(R * lda + C) * 2u; voffB[i] = (unsigned)(Rb * ldb + C) * 2u; }
    const size_t kstep = (size_t)(BK * 2);
    const size_t hstepA = (size_t)HALF * lda * 2, hstepB = (size_t)HALF * ldb * 2;
    const unsigned ldsw = (unsigned)wid * 1024u;
    const int aoff = lds_byte(wr * 64 + fr, fq * 8), boff = lds_byte(wc * 32 + fr, fq * 8);
#define G_SA(b, h) (((b) * 2 + (h)) * HTB)
#define G_SB(b, h) ((4 + (b) * 2 + (h)) * HTB)
#define G_STAGE(bufoff, gbase, voff) do { _Pragma("unroll") for (int _i = 0; _i < 2; ++_i) \
        __builtin_amdgcn_global_load_lds((const unsigned*)((const char*)(gbase) + (voff)[_i]), (LAS unsigned*)(lds + (bufoff) + ldsw + _i * 8192), 16, 0, 0); } while (0)
#define G_LDA(dst, b, h) do { _Pragma("unroll") for (int m = 0; m < 4; ++m) _Pragma("unroll") for (int k = 0; k < 2; ++k) dst[m][k] = *(const LAS bf16x8*)(lds + G_SA(b, h) + aoff + m * 2048 + k * 1024); } while (0)
#define G_LDB(dst, b, h) do { _Pragma("unroll") for (int n = 0; n < 2; ++n) _Pragma("unroll") for (int k = 0; k < 2; ++k) dst[n][k] = *(const LAS bf16x8*)(lds + G_SB(b, h) + boff + n * 2048 + k * 1024); } while (0)
#define G_MMA(ai, bj, At, Bt) do { __builtin_amdgcn_s_setprio(1); _Pragma("unroll") for (int m = 0; m < 4; ++m) _Pragma("unroll") for (int n = 0; n < 2; ++n) _Pragma("unroll") for (int k = 0; k < 2; ++k) \
        acc[ai][bj][m][n] = __builtin_amdgcn_mfma_f32_16x16x32_bf16(Bt[n][k], At[m][k], acc[ai][bj][m][n], 0, 0, 0); __builtin_amdgcn_s_setprio(0); } while (0)
#define G_WAIT_V(n) asm volatile("s_waitcnt vmcnt(" #n ")" ::: "memory")
#define G_WAIT_L(n) asm volatile("s_waitcnt lgkmcnt(" #n ")" ::: "memory")
#define G_BAR __builtin_amdgcn_s_barrier()
#define G_SCHED __builtin_amdgcn_sched_barrier(0)
    Unit cur, nxt; int ui = 0;
    if (!S.next(0, cur)) return;
    Acc acc;
#pragma unroll
    for (int a = 0; a < 2; ++a)
#pragma unroll
        for (int b = 0; b < 2; ++b)
#pragma unroll
            for (int m = 0; m < 4; ++m)
#pragma unroll
                for (int n = 0; n < 2; ++n) acc[a][b][m][n] = (f32x4){0.f, 0.f, 0.f, 0.f};
    bf16x8 At[4][2], B0[2][2], B1[2][2];
    const char* cA = cur.A; const char* cB = cur.B;
    G_STAGE(G_SB(0, 0), cB, voffB); G_STAGE(G_SB(0, 1), cB + hstepB, voffB); G_STAGE(G_SA(0, 0), cA, voffA); G_STAGE(G_SA(0, 1), cA + hstepA, voffA);
    if (wr == 1) G_BAR;
    G_WAIT_V(2); G_BAR;
    G_STAGE(G_SB(1, 0), cB + kstep, voffB); G_STAGE(G_SA(1, 0), cA + kstep, voffA); G_STAGE(G_SB(1, 1), cB + hstepB + kstep, voffB);
    G_WAIT_V(6); G_BAR;
    for (;;) {
        const bool has_next = S.next(ui + 1, nxt);
        const char* nA = has_next ? nxt.A : cA; const char* nB = has_next ? nxt.B : cB;
#pragma unroll 1
        for (int t = 0; t < nt; t += 2) {
            const bool last = (t == nt - 2);
            const char* a1 = cA + (size_t)(t + 1) * kstep;
            const char* a2 = last ? nA : cA + (size_t)(t + 2) * kstep; const char* b2 = last ? nB : cB + (size_t)(t + 2) * kstep;
            const char* a3 = a2 + kstep; const char* b3 = b2 + kstep;
            G_LDB(B0, 0, 0); G_LDB(B1, 0, 1); G_SCHED; G_LDA(At, 0, 0); G_STAGE(G_SA(1, 1), a1 + hstepA, voffA);
            G_WAIT_V(8); G_WAIT_L(0); G_BAR; G_MMA(0, 0, At, B0); G_MMA(0, 1, At, B1); G_BAR; G_SCHED;
            G_LDA(At, 0, 1); G_STAGE(G_SB(0, 0), b2, voffB); G_STAGE(G_SB(0, 1), b2 + hstepB, voffB); G_STAGE(G_SA(0, 0), a2, voffA);
            G_WAIT_V(8); G_WAIT_L(0); G_BAR; G_MMA(1, 0, At, B0); G_MMA(1, 1, At, B1); G_BAR; G_SCHED;
            G_LDB(B0, 1, 0); G_LDB(B1, 1, 1); G_SCHED; G_LDA(At, 1, 0); G_STAGE(G_SA(0, 1), a2 + hstepA, voffA);
            G_WAIT_V(8); G_WAIT_L(0); G_BAR; G_MMA(0, 0, At, B0); G_MMA(0, 1, At, B1); G_BAR; G_SCHED;
            G_LDA(At, 1, 1); G_STAGE(G_SB(1, 0), b3, voffB); G_STAGE(G_SB(1, 1), b3 + hstepB, voffB); G_STAGE(G_SA(1, 0), a3, voffA);
            G_WAIT_V(8); G_WAIT_L(0); G_BAR; G_MMA(1, 0, At, B0); G_MMA(1, 1, At, B1); G_BAR; G_SCHED;
        }
        if (wr == 0) G_BAR;
        if constexpr (!Epi::AFTER_DRAIN) E(acc, cur, wr, wc, fr, fq);
        if (!has_next) break;
#pragma unroll
        for (int a = 0; a < 2; ++a)
#pragma unroll
            for (int b = 0; b < 2; ++b)
#pragma unroll
                for (int m = 0; m < 4; ++m)
#pragma unroll
                    for (int n = 0; n < 2; ++n) acc[a][b][m][n] = (f32x4){0.f, 0.f, 0.f, 0.f};
        cur = nxt; cA = nA; cB = nB; ++ui;
        if (wr == 1) G_BAR;
    }
    G_WAIT_V(0);
    G_BAR;
    if constexpr (Epi::AFTER_DRAIN) E.fused(acc, cur, wr, wc, fr, fq, lds);
#undef G_SA
#undef G_SB
#undef G_STAGE
#undef G_LDA
#undef G_LDB
#undef G_MMA
#undef G_WAIT_V
#undef G_WAIT_L
#undef G_BAR
#undef G_SCHED
}

struct EpiGluH {
    static constexpr bool AFTER_DRAIN = false;
    bf16_t* H;
    __device__ __forceinline__ void operator()(Acc& acc, const Unit& u, int wr, int wc, int fr, int fq) const {
#pragma unroll
        for (int ai = 0; ai < 2; ++ai)
#pragma unroll
            for (int m = 0; m < 4; ++m) {
                const int r = u.r0 + 128 * ai + 64 * wr + 16 * m + fr;
                if (r < M) {
                    float h[8];
#pragma unroll
                    for (int n = 0; n < 2; ++n)
#pragma unroll
                        for (int j = 0; j < 4; ++j) h[4 * n + j] = silu_f(acc[ai][0][m][n][j]) * acc[ai][1][m][n][j];
                    u32x4 w; w.x = cvt_pk_bf16(h[0], h[1]); w.y = cvt_pk_bf16(h[2], h[3]); w.z = cvt_pk_bf16(h[4], h[5]); w.w = cvt_pk_bf16(h[6], h[7]);
                    *(u32x4*)(H + (size_t)r * FF + 128 * u.tn + 32 * wc + 8 * fq) = w;
                }
            }
    }
};
struct EpiResid {
    static constexpr bool AFTER_DRAIN = false;
    bf16_t* Z; const float* res0; const float* res1; float scale;
    __device__ __forceinline__ void operator()(Acc& acc, const Unit& u, int wr, int wc, int fr, int fq) const {
#pragma unroll
        for (int ai = 0; ai < 2; ++ai)
#pragma unroll
            for (int m = 0; m < 4; ++m) {
                const int r = u.r0 + 128 * ai + 64 * wr + 16 * m + fr;
                if (r < M) {
                    const float* rp = (r < MP) ? res0 + (size_t)r * D : res1 + (size_t)(r - MP) * D;
                    bf16_t* zp = Z + (size_t)r * D;
#pragma unroll
                    for (int bj = 0; bj < 2; ++bj) {
                        const int c = u.c0 + 128 * bj + 32 * wc + 8 * fq;
                        const f32x4 v0 = *(const f32x4*)(rp + c) * ALPHA + acc[ai][bj][m][0] * scale, v1 = *(const f32x4*)(rp + c + 4) * ALPHA + acc[ai][bj][m][1] * scale;
                        u32x4 w; w.x = cvt_pk_bf16(v0[0], v0[1]); w.y = cvt_pk_bf16(v0[2], v0[3]); w.z = cvt_pk_bf16(v1[0], v1[1]); w.w = cvt_pk_bf16(v1[2], v1[3]);
                        *(u32x4*)(zp + c) = w;
                    }
                }
            }
    }
};
struct EpiResidB {
    static constexpr bool AFTER_DRAIN = false;
    bf16_t* Z; const bf16_t* res; float scale;
    __device__ __forceinline__ void operator()(Acc& acc, const Unit& u, int wr, int wc, int fr, int fq) const {
#pragma unroll
        for (int ai = 0; ai < 2; ++ai)
#pragma unroll
            for (int m = 0; m < 4; ++m) {
                const int r = u.r0 + 128 * ai + 64 * wr + 16 * m + fr;
                const bf16_t* rp = res + (size_t)r * D; bf16_t* zp = Z + (size_t)r * D;
#pragma unroll
                for (int bj = 0; bj < 2; ++bj) {
                    const int c = u.c0 + 128 * bj + 32 * wc + 8 * fq;
                    const u32x4 rb = *(const u32x4*)(rp + c);
                    f32x4 r0, r1;
                    r0[0] = __builtin_bit_cast(float, rb[0] << 16); r0[1] = __builtin_bit_cast(float, rb[0] & 0xffff0000u); r0[2] = __builtin_bit_cast(float, rb[1] << 16); r0[3] = __builtin_bit_cast(float, rb[1] & 0xffff0000u);
                    r1[0] = __builtin_bit_cast(float, rb[2] << 16); r1[1] = __builtin_bit_cast(float, rb[2] & 0xffff0000u); r1[2] = __builtin_bit_cast(float, rb[3] << 16); r1[3] = __builtin_bit_cast(float, rb[3] & 0xffff0000u);
                    const f32x4 v0 = r0 * ALPHA + acc[ai][bj][m][0] * scale, v1 = r1 * ALPHA + acc[ai][bj][m][1] * scale;
                    u32x4 w; w.x = cvt_pk_bf16(v0[0], v0[1]); w.y = cvt_pk_bf16(v0[2], v0[3]); w.z = cvt_pk_bf16(v1[0], v1[1]); w.w = cvt_pk_bf16(v1[2], v1[3]);
                    *(u32x4*)(zp + c) = w;
                }
            }
    }
};
struct EpiPart {
    static constexpr bool AFTER_DRAIN = false;
    float* PART;
    __device__ __forceinline__ void operator()(Acc& acc, const Unit& u, int wr, int wc, int fr, int fq) const {
#pragma unroll
        for (int m = 0; m < 4; ++m) {
            const int rl = 64 * wr + 16 * m + fr;
            float* pp = PART + ((size_t)u.tn * 128 + rl) * D;
#pragma unroll
            for (int bj = 0; bj < 2; ++bj)
#pragma unroll
                for (int n = 0; n < 2; ++n) *(f32x4*)(pp + u.c0 + 128 * bj + 32 * wc + 8 * fq + 4 * n) = acc[0][bj][m][n];
        }
    }
};
struct EpiWin {
    static constexpr bool AFTER_DRAIN = false;
    float* PS; float* U;
    __device__ __forceinline__ void operator()(Acc& acc, const Unit& u, int wr, int wc, int fr, int fq) const {
#pragma unroll
        for (int ai = 0; ai < 2; ++ai)
#pragma unroll
            for (int m = 0; m < 4; ++m) {
                const int r = u.r0 + 128 * ai + 64 * wr + 16 * m + fr;
                if (r < M) {
                    if (u.tn < 14) {
#pragma unroll
                        for (int bj = 0; bj < 2; ++bj)
#pragma unroll
                            for (int n = 0; n < 2; ++n) {
                                const int c = u.c0 + 128 * bj + 32 * wc + 8 * fq + 4 * n;
                                if (c < SC) *(f32x4*)(PS + (size_t)r * SC + c) = acc[ai][bj][m][n];
                            }
                    } else {
#pragma unroll
                        for (int n = 0; n < 2; ++n) {
                            const int c = 128 * (u.tn - 14) + 32 * wc + 8 * fq + 4 * n;
                            f32x4 o;
#pragma unroll
                            for (int j = 0; j < 4; ++j) o[j] = acc[ai][0][m][n][j] * sigmoid_f(acc[ai][1][m][n][j]);
                            *(f32x4*)(U + (size_t)r * DC + c) = o;
                        }
                    }
                }
            }
    }
};
struct EpiLora {
    static constexpr bool AFTER_DRAIN = false;
    float* DAG; const float* w0; const float* a0;
    __device__ __forceinline__ void operator()(Acc& acc, const Unit& u, int wr, int wc, int fr, int fq) const {
        const int sec = u.tn >> 2;
#pragma unroll
        for (int ai = 0; ai < 2; ++ai)
#pragma unroll
            for (int m = 0; m < 4; ++m) {
                const int r = u.r0 + 128 * ai + 64 * wr + 16 * m + fr;
                if (r < M) {
#pragma unroll
                    for (int bj = 0; bj < 2; ++bj)
#pragma unroll
                        for (int n = 0; n < 2; ++n) {
                            const int c = u.c0 + 128 * bj + 32 * wc + 8 * fq + 4 * n, cc = c & 1023;
                            f32x4 o = acc[ai][bj][m][n];
                            if (sec == 0) {
                                const f32x4 wv = *(const f32x4*)(w0 + cc);
#pragma unroll
                                for (int j = 0; j < 4; ++j) o[j] = __expf(-0.6065306597126334f * sigmoid_f(wv[j] + o[j]));
                            } else if (sec == 1) {
                                const f32x4 av = *(const f32x4*)(a0 + cc);
#pragma unroll
                                for (int j = 0; j < 4; ++j) o[j] = sigmoid_f(av[j] + o[j]);
                            }
                            *(f32x4*)(DAG + (size_t)r * 3072 + c) = o;
                        }
                }
            }
    }
};
struct EpiBf16 {
    static constexpr bool AFTER_DRAIN = false;
    bf16_t* O; int ldc; float scale; int rlim;
    __device__ __forceinline__ void operator()(Acc& acc, const Unit& u, int wr, int wc, int fr, int fq) const {
#pragma unroll
        for (int ai = 0; ai < 2; ++ai)
#pragma unroll
            for (int m = 0; m < 4; ++m) {
                const int r = u.r0 + 128 * ai + 64 * wr + 16 * m + fr;
                if (r < rlim) {
#pragma unroll
                    for (int bj = 0; bj < 2; ++bj) {
                        const f32x4 v0 = acc[ai][bj][m][0] * scale, v1 = acc[ai][bj][m][1] * scale;
                        u32x4 w; w.x = cvt_pk_bf16(v0[0], v0[1]); w.y = cvt_pk_bf16(v0[2], v0[3]); w.z = cvt_pk_bf16(v1[0], v1[1]); w.w = cvt_pk_bf16(v1[2], v1[3]);
                        *(u32x4*)(O + (size_t)r * ldc + u.c0 + 128 * bj + 32 * wc + 8 * fq) = w;
                    }
                }
            }
    }
};
struct EpiMemKV {
    static constexpr bool AFTER_DRAIN = false;
    float* outK; float* outV; bf16_t* KB; bf16_t* VT;
    __device__ __forceinline__ void operator()(Acc& acc, const Unit& u, int wr, int wc, int fr, int fq) const {
#pragma unroll
        for (int ai = 0; ai < 2; ++ai)
#pragma unroll
            for (int m = 0; m < 4; ++m) {
                const int r = u.r0 + 128 * ai + 64 * wr + 16 * m + fr;
#pragma unroll
                for (int bj = 0; bj < 2; ++bj) {
                    const int c = u.c0 + 128 * bj + 32 * wc + 8 * fq;
                    const f32x4 v0 = acc[ai][bj][m][0], v1 = acc[ai][bj][m][1];
                    if (u.tn < 8) {
                        __builtin_nontemporal_store(v0, (f32x4*)(outK + (size_t)r * D + c)); __builtin_nontemporal_store(v1, (f32x4*)(outK + (size_t)r * D + c + 4));
                        u32x4 w; w.x = cvt_pk_bf16(v0[0], v0[1]); w.y = cvt_pk_bf16(v0[2], v0[3]); w.z = cvt_pk_bf16(v1[0], v1[1]); w.w = cvt_pk_bf16(v1[2], v1[3]);
                        *(u32x4*)(KB + (size_t)r * D + c) = w;
                    } else {
                        const int cv = c - D;
                        __builtin_nontemporal_store(v0, (f32x4*)(outV + (size_t)r * D + cv)); __builtin_nontemporal_store(v1, (f32x4*)(outV + (size_t)r * D + cv + 4));
                        bf16_t* vt = VT + ((size_t)(r >> 8) * D + cv) * NMEM + (r & 255);
#pragma unroll
                        for (int j = 0; j < 4; ++j) { vt[(size_t)j * NMEM] = f2bf(v0[j]); vt[(size_t)(4 + j) * NMEM] = f2bf(v1[j]); }
                    }
                }
            }
    }
};
struct EpiSoftmax {
    static constexpr bool AFTER_DRAIN = true;
    bf16_t* P;
    __device__ __forceinline__ void operator()(Acc&, const Unit&, int, int, int, int) const {}
    __device__ __forceinline__ void fused(Acc& acc, const Unit& u, int wr, int wc, int fr, int fq, LAS unsigned char* lds) const {
        LAS float* red = (LAS float*)lds;
        LAS float* red2 = red + 1024;
#pragma unroll
        for (int ai = 0; ai < 2; ++ai)
#pragma unroll
            for (int m = 0; m < 4; ++m) {
                float v = -3.0e38f;
#pragma unroll
                for (int bj = 0; bj < 2; ++bj)
#pragma unroll
                    for (int n = 0; n < 2; ++n)
#pragma unroll
                        for (int j = 0; j < 4; ++j) v = fmaxf(v, acc[ai][bj][m][n][j]);
                v = fmaxf(v, __shfl_xor(v, 16)); v = fmaxf(v, __shfl_xor(v, 32));
                if (fq == 0) red[wc * 256 + 128 * ai + 64 * wr + 16 * m + fr] = v;
            }
        __syncthreads();
#pragma unroll
        for (int ai = 0; ai < 2; ++ai)
#pragma unroll
            for (int m = 0; m < 4; ++m) {
                const int rl = 128 * ai + 64 * wr + 16 * m + fr;
                const float mx = fmaxf(fmaxf(red[rl], red[256 + rl]), fmaxf(red[512 + rl], red[768 + rl]));
                float s = 0.f;
#pragma unroll
                for (int bj = 0; bj < 2; ++bj)
#pragma unroll
                    for (int n = 0; n < 2; ++n)
#pragma unroll
                        for (int j = 0; j < 4; ++j) { const float e = __expf(acc[ai][bj][m][n][j] - mx); acc[ai][bj][m][n][j] = e; s += e; }
                s += __shfl_xor(s, 16); s += __shfl_xor(s, 32);
                if (fq == 0) red2[wc * 256 + rl] = s;
            }
        __syncthreads();
#pragma unroll
        for (int ai = 0; ai < 2; ++ai)
#pragma unroll
            for (int m = 0; m < 4; ++m) {
                const int rl = 128 * ai + 64 * wr + 16 * m + fr;
                const float inv = 1.f / ((red2[rl] + red2[256 + rl]) + (red2[512 + rl] + red2[768 + rl]));
#pragma unroll
                for (int bj = 0; bj < 2; ++bj) {
                    const f32x4 v0 = acc[ai][bj][m][0] * inv, v1 = acc[ai][bj][m][1] * inv;
                    u32x4 w; w.x = cvt_pk_bf16(v0[0], v0[1]); w.y = cvt_pk_bf16(v0[2], v0[3]); w.z = cvt_pk_bf16(v1[0], v1[1]); w.w = cvt_pk_bf16(v1[2], v1[3]);
                    *(u32x4*)(P + (size_t)(u.r0 + rl) * 1024 + u.c0 + 128 * bj + 32 * wc + 8 * fq) = w;
                }
            }
        __syncthreads();
    }
};

__device__ __forceinline__ void transpose_item(const float* W, int K, int N, bf16_t* WT, int k0, int n0, int drow0, LAS float* scr, int lane, bool late = false) {
    float tv[32];
#pragma unroll
    for (int i = 0; i < 32; ++i) tv[i] = __builtin_nontemporal_load(W + (size_t)(k0 + 2 * i + (lane >> 5)) * N + n0 + (lane & 31));
#pragma unroll
    for (int i = 0; i < 32; ++i) scr[(2 * i + (lane >> 5)) * 33 + (lane & 31)] = tv[i];
    asm volatile("s_waitcnt lgkmcnt(0)" ::: "memory");
    const int c = lane & 7;
#pragma unroll
    for (int j = 0; j < 4; ++j) { const int n = (lane >> 3) + 8 * j; const LAS float* s = scr + (8 * c) * 33 + n;
        u32x4 o; o.x = cvt_pk_bf16(s[0 * 33], s[1 * 33]); o.y = cvt_pk_bf16(s[2 * 33], s[3 * 33]); o.z = cvt_pk_bf16(s[4 * 33], s[5 * 33]); o.w = cvt_pk_bf16(s[6 * 33], s[7 * 33]);
        if (late) __builtin_nontemporal_store(o, (u32x4*)(WT + (size_t)(drow0 + n) * K + k0 + 8 * c)); else *(u32x4*)(WT + (size_t)(drow0 + n) * K + k0 + 8 * c) = o; }
    asm volatile("s_waitcnt lgkmcnt(0)" ::: "memory");
}
__device__ __forceinline__ int glu_row(int n0, int which) { return (n0 >> 7) * 256 + which * 128 + (n0 & 127); }
__device__ __forceinline__ int win_row(int n0) {
    if (n0 < SC) return n0;
    if (n0 < SC + DC) return 3584 + glu_row(n0 - SC, 0);
    return 3584 + glu_row(n0 - SC - DC, 1);
}
__device__ __forceinline__ void phase_prep(const Params& p, LAS unsigned char* lds, int G, int bid) {
    const int tid = threadIdx.x, lane = tid & 63, wid = tid >> 6;
    const int gw = bid * 8 + wid, NGW = G * 8;
    LAS float* scr = (LAS float*)(lds + wid * 8704);
    unsigned char* ws = p.ws;
    constexpr int I_FF = (D / 64) * (FF / 32);
    constexpr int I_IN = (D / 64) * (5408 / 32);
    constexpr int I_SQ = (D / 64) * (D / 32);
    constexpr int NITEMS = 6 * I_FF + I_IN + 5 * I_SQ;
    for (int it = gw; it < NITEMS; it += NGW) {
        int r = NITEMS - 1 - it;
        if (r < 6 * I_FF) {
            const int which = r / I_FF; r -= which * I_FF;
            const int layer = which / 3, kind = which % 3;
            if (kind < 2) {
                const float* W = p.in[layer ? (kind ? I_F2W3 : I_F2W1) : (kind ? I_F1W3 : I_F1W1)];
                bf16_t* WT = (bf16_t*)(ws + (layer ? WS_W13B : WS_W13A));
                const int nblk = FF / 32, kb = r / nblk, nb = r % nblk;
                transpose_item(W, D, FF, WT, kb * 64, nb * 32, glu_row(nb * 32, kind), scr, lane, layer != 0);
            } else {
                const float* W = p.in[layer ? I_F2W2 : I_F1W2];
                bf16_t* WT = (bf16_t*)(ws + (layer ? WS_W2B : WS_W2A));
                const int nblk = D / 32, kb = r / nblk, nb = r % nblk;
                transpose_item(W, FF, D, WT, kb * 64, nb * 32, nb * 32, scr, lane, layer != 0);
            }
            continue;
        }
        r -= 6 * I_FF;
        if (r < I_IN) {
            const int nblk = 5408 / 32, kb = r / nblk, nb = r % nblk;
            transpose_item(p.in[I_WIN], D, 5408, (bf16_t*)(ws + WS_WIN), kb * 64, nb * 32, win_row(nb * 32), scr, lane);
            continue;
        }
        r -= I_IN;
        {
            const int which = r / I_SQ; r -= which * I_SQ;
            const int idx = which == 0 ? I_WOUT : which == 1 ? I_WMQ : which == 2 ? I_WMK : which == 3 ? I_WMV : I_WMO;
            const size_t off = which == 0 ? WS_WOUT : which == 1 ? WS_WMQ : which == 2 ? WS_WMK : which == 3 ? WS_WMV : WS_WMO;
            const int nblk = D / 32, kb = r / nblk, nb = r % nblk;
            transpose_item(p.in[idx], D, D, (bf16_t*)(ws + off), kb * 64, nb * 32, nb * 32, scr, lane, which != 2 && which != 3);
        }
    }
    const int gt = bid * 512 + tid, NGT = G * 512;
    { u32x4* z = (u32x4*)(ws + WS_WIN + (size_t)SC * D * 2); const int n16 = (3584 - SC) * D * 2 / 16;
      for (int i = gt; i < n16; i += NGT) z[i] = (u32x4){0u, 0u, 0u, 0u}; }
    { bf16_t* WL = (bf16_t*)(ws + WS_WLORA);
      for (int i = gt; i < 3072 * LK; i += NGT) {
          const int n = i / LK, k = i % LK; float v = 0.f;
          if (n < 1024) { if (k < 64) v = p.in[I_W2D][(size_t)k * DR + n]; }
          else if (n < 2048) { if (k >= 64 && k < 128) v = p.in[I_A2][(size_t)(k - 64) * DR + (n - 1024)]; }
          else { if (k >= 128 && k < 288) v = p.in[I_G2][(size_t)(k - 128) * DR + (n - 2048)]; }
          WL[i] = f2bf(v);
      } }
    { u32x2* xb = (u32x2*)(ws + WS_XB); const f32x4* xp = (const f32x4*)p.in[I_XP]; const f32x4* xs = (const f32x4*)p.in[I_XS];
      constexpr int NP4 = MP * D / 4, NA4 = M * D / 4;
      for (int i = gt; i < NA4; i += NGT) { const f32x4 v = (i < NP4) ? xp[i] : xs[i - NP4]; xb[i] = (u32x2){cvt_pk_bf16(v[0], v[1]), cvt_pk_bf16(v[2], v[3])}; }
      u32x2* mb = (u32x2*)(ws + WS_MEMB); const f32x4* mp = (const f32x4*)p.in[I_MEM];
      for (int i = gt; i < 1024 * D / 4; i += NGT) { const f32x4 v = mp[i]; mb[i] = (u32x2){cvt_pk_bf16(v[0], v[1]), cvt_pk_bf16(v[2], v[3])}; } }
}

__device__ __forceinline__ void ln_finish(f32x4 (&v)[8], int row, int lane, const float* g, const float* b, float* outF, bf16_t* outB) {
    float s = 0.f;
#pragma unroll
    for (int j = 0; j < 8; ++j) s += (v[j][0] + v[j][1]) + (v[j][2] + v[j][3]);
    const float mean = wave_sum(s) * (1.f / D); float s2 = 0.f;
#pragma unroll
    for (int j = 0; j < 8; ++j) { v[j] = v[j] - mean; s2 += (v[j][0] * v[j][0] + v[j][1] * v[j][1]) + (v[j][2] * v[j][2] + v[j][3] * v[j][3]); }
    const float rstd = 1.f / sqrtf(wave_sum(s2) * (1.f / D) + LN_EPS);
#pragma unroll
    for (int j = 0; j < 8; ++j) {
        const f32x4 gv = ((const f32x4*)g)[64 * j + lane], bv = ((const f32x4*)b)[64 * j + lane];
        const f32x4 y = v[j] * rstd * gv + bv;
        if (outF) __builtin_nontemporal_store(y, (f32x4*)(outF + (size_t)row * D) + 64 * j + lane);
        if (outB) ((u32x2*)(outB + (size_t)row * D))[64 * j + lane] = (u32x2){cvt_pk_bf16(y[0], y[1]), cvt_pk_bf16(y[2], y[3])};
    }
}
__device__ __forceinline__ void phase_ln(LAS unsigned char* lds, const bf16_t* Z, const float* g, const float* b, float* outF, bf16_t* outB, int G, int bid, const float* PART, int nsl, const float* res1, const bf16_t* res1b, float scale) {
    const int tid = threadIdx.x, lane = tid & 63, wid = tid >> 6;
    const int gw = bid * 8 + wid, NGW = G * 8;
    {
        f32x4 cur[8], nxt[8];
        int row = gw;
        if (row < MP) {
#pragma unroll
            for (int j = 0; j < 8; ++j) { const u32x2 zb = ((const u32x2*)(Z + (size_t)row * D))[64 * j + lane]; cur[j][0] = __builtin_bit_cast(float, zb[0] << 16); cur[j][1] = __builtin_bit_cast(float, zb[0] & 0xffff0000u); cur[j][2] = __builtin_bit_cast(float, zb[1] << 16); cur[j][3] = __builtin_bit_cast(float, zb[1] & 0xffff0000u); }
        }
#pragma unroll 1
        while (row < MP) {
            const int nrow = row + NGW;
            if (nrow < MP) {
#pragma unroll
                for (int j = 0; j < 8; ++j) { const u32x2 zb = ((const u32x2*)(Z + (size_t)nrow * D))[64 * j + lane]; nxt[j][0] = __builtin_bit_cast(float, zb[0] << 16); nxt[j][1] = __builtin_bit_cast(float, zb[0] & 0xffff0000u); nxt[j][2] = __builtin_bit_cast(float, zb[1] << 16); nxt[j][3] = __builtin_bit_cast(float, zb[1] & 0xffff0000u); }
            }
            ln_finish(cur, row, lane, g, b, outF, outB);
#pragma unroll
            for (int j = 0; j < 8; ++j) cur[j] = nxt[j];
            row = nrow;
        }
    }
    if (bid < MS) {
        const int sr = bid;
        LAS float* red = (LAS float*)lds;
        f32x4 a = (f32x4){0.f, 0.f, 0.f, 0.f};
#pragma unroll
        for (int sl = 0; sl < 22; ++sl) if (sl < nsl) a += ((const f32x4*)(PART + ((size_t)sl * 128 + sr) * D))[64 * wid + lane];
        f32x4 rv;
        if (res1) rv = ((const f32x4*)(res1 + (size_t)sr * D))[64 * wid + lane];
        else { const u32x2 rb = ((const u32x2*)(res1b + (size_t)sr * D))[64 * wid + lane];
               rv[0] = __builtin_bit_cast(float, rb[0] << 16); rv[1] = __builtin_bit_cast(float, rb[0] & 0xffff0000u); rv[2] = __builtin_bit_cast(float, rb[1] << 16); rv[3] = __builtin_bit_cast(float, rb[1] & 0xffff0000u); }
        f32x4 v = rv * ALPHA + a * scale;
        const float ps = wave_sum((v[0] + v[1]) + (v[2] + v[3]));
        if (lane == 0) red[wid] = ps;
        __syncthreads();
        const float mean = (((red[0] + red[1]) + (red[2] + red[3])) + ((red[4] + red[5]) + (red[6] + red[7]))) * (1.f / D);
        v = v - mean;
        const float ps2 = wave_sum((v[0] * v[0] + v[1] * v[1]) + (v[2] * v[2] + v[3] * v[3]));
        if (lane == 0) red[8 + wid] = ps2;
        __syncthreads();
        const float rstd = 1.f / sqrtf((((red[8] + red[9]) + (red[10] + red[11])) + ((red[12] + red[13]) + (red[14] + red[15]))) * (1.f / D) + LN_EPS);
        const f32x4 gv = ((const f32x4*)g)[64 * wid + lane], bv = ((const f32x4*)b)[64 * wid + lane];
        const f32x4 y = v * rstd * gv + bv;
        if (outF) __builtin_nontemporal_store(y, (f32x4*)(outF + (size_t)(MP + sr) * D) + 64 * wid + lane);
        if (outB) ((u32x2*)(outB + (size_t)(MP + sr) * D))[64 * wid + lane] = (u32x2){cvt_pk_bf16(y[0], y[1]), cvt_pk_bf16(y[2], y[3])};
        __syncthreads();
    }
}

__device__ __forceinline__ void load_rkv_raw(const Params& p, int row, int ch, float (&c)[3], float (&q)[3]) {
    const float* PS = (const float*)(p.ws + WS_RA);
    const float* cur = PS + (size_t)row * SC;
    const float* prev;
    if (row < MP) { const int t = row & (SEQ - 1); prev = PS + (size_t)(row - (t ? 1 : 0)) * SC; }
    else prev = p.in[I_SSH] + (size_t)(row - MP) * SC;
    c[0] = cur[ch]; c[1] = cur[1024 + ch]; c[2] = cur[2048 + ch];
    q[0] = prev[ch]; q[1] = prev[1024 + ch]; q[2] = prev[2048 + ch];
}
__device__ __forceinline__ void load_rkv_cur(const Params& p, int row, int ch, float (&c)[3]) {
    const float* cur = (const float*)(p.ws + WS_RA) + (size_t)row * SC;
    c[0] = cur[ch]; c[1] = cur[1024 + ch]; c[2] = cur[2048 + ch];
}
__device__ __forceinline__ void load_rkv_prev(const Params& p, int row, int ch, float (&q)[3]) {
    const int t = row & (SEQ - 1);
    const float* prev = (const float*)(p.ws + WS_RA) + (size_t)(row - (t ? 1 : 0)) * SC;
    q[0] = prev[ch]; q[1] = prev[1024 + ch]; q[2] = prev[2048 + ch];
}
__device__ __forceinline__ float shift_mix(float c, float q, float mu, bool zprev) { const float pq = zprev ? 0.f : q; return c + mu * (pq - c); }
__device__ __forceinline__ void phase_mixpre(const Params& p, int G, int bid) {
    const int tid = threadIdx.x, lane = tid & 63, wid = tid >> 6;
    const int gw = bid * 8 + wid, NGW = G * 8;
    unsigned char* ws = p.ws;
    const float* PS = (const float*)(ws + WS_RA); bf16_t* LA = (bf16_t*)(ws + WS_LA);
    const float* mu = p.in[I_MU];
    for (int row = gw; row < M; row += NGW) {
        const f32x4* cur = (const f32x4*)(PS + (size_t)row * SC);
        const f32x4* prev; bool zprev = false; float* shout = nullptr;
        if (row < MP) { const int t = row & (SEQ - 1); zprev = (t == 0); prev = (const f32x4*)(PS + (size_t)(row - (zprev ? 0 : 1)) * SC);
                        if (t == SEQ - 1) shout = p.out + O_SHP + (size_t)(row >> 11) * SC; }
        else { prev = (const f32x4*)(p.in[I_SSH] + (size_t)(row - MP) * SC); shout = p.out + O_SHS + (size_t)(row - MP) * SC; }
        if (shout) for (int i = lane; i < SC / 4; i += 64) ((f32x4*)shout)[i] = cur[i];
        for (int i = 768 + lane; i < SC / 4; i += 64) {
            const f32x4 c = cur[i]; f32x4 pv = prev[i]; if (zprev) pv = (f32x4){0.f, 0.f, 0.f, 0.f};
            const f32x4 m4 = ((const f32x4*)mu)[i];
            const f32x4 pm = c + m4 * (pv - c);
            const int col = 4 * i;
            f32x4 a;
            if (col < 3136) { for (int j = 0; j < 4; ++j) a[j] = tanhf(pm[j]); }
            else if (col < 3200) a = pm;
            else { for (int j = 0; j < 4; ++j) a[j] = 1.f / (1.f + expf(-pm[j])); }
            *(u32x2*)(LA + (size_t)row * LK + (col - 3072)) = (u32x2){cvt_pk_bf16(a[0], a[1]), cvt_pk_bf16(a[2], a[3])};
        }
        if (lane < 24) *(u32x2*)(LA + (size_t)row * LK + 288 + 4 * lane) = (u32x2){0u, 0u};
    }
    const int gt = bid * 512 + tid, NGT = G * 512;
    const f32x4* U4 = (const f32x4*)(ws + WS_U);
    { f32x4* o = (f32x4*)(p.out + O_CVP);
      for (int i = gt; i < NB * 30 * DC / 4; i += NGT) { const int c4 = i & 255, j = (i >> 8) % 30, b = (i >> 8) / 30; __builtin_nontemporal_store(U4[(size_t)(b * SEQ + SEQ - 30 + j) * 256 + c4], o + i); } }
    { f32x4* o = (f32x4*)(p.out + O_CVS); const f32x4* sc = (const f32x4*)p.in[I_SCV];
      for (int i = gt; i < MS * 30 * DC / 4; i += NGT) { const int c4 = i & 255, j = (i >> 8) % 30, s = (i >> 8) / 30;
          const f32x4 val = (j < 29) ? sc[(size_t)(s * 30 + j + 1) * 256 + c4] : U4[(size_t)(MP + s) * 256 + c4]; __builtin_nontemporal_store(val, o + i); } }
}

constexpr int TC = 32;
__device__ __forceinline__ void rwkv_sample8(const Params& p, LAS unsigned char* lds, int j0) {
    LAS float* sR = (LAS float*)lds; LAS float* sK = sR + 8 * 64; LAS float* sV = sK + 8 * 64; LAS float* sW = sV + 8 * 64;
    LAS float* sKK = sW + 8 * 64; LAS float* sB = sKK + 8 * 64; LAS float* sY = sB + 8 * 64;
    const int tid = threadIdx.x, lane = tid & 63, wid = tid >> 6;
    const int v = wid * 8 + (lane >> 3), kq = lane & 7;
    const float* DAG = (const float*)(p.ws + WS_RB); bf16_t* OMIX = (bf16_t*)(p.ws + WS_OMIX);
    const int jw = j0 + wid, sw = jw >> 4, hw = jw & 15, roww = MP + sw, ch = hw * 64 + lane;
    const float rk_w = p.in[I_RK][ch], gng = p.in[I_GNG][ch], gnb = p.in[I_GNB][ch], beta = p.in[I_BR][ch];
    {
        const float mu_r = p.in[I_MU][ch], mu_k = p.in[I_MU][1024 + ch], mu_v = p.in[I_MU][2048 + ch], kk_w = p.in[I_KK][ch], ka_w = p.in[I_KA][ch];
        const float* dag = DAG + (size_t)roww * 3072;
        float cc[3], qq[3]; load_rkv_raw(p, roww, ch, cc, qq);
        const float r = shift_mix(cc[0], qq[0], mu_r, false), k = shift_mix(cc[1], qq[1], mu_k, false), vv = shift_mix(cc[2], qq[2], mu_v, false), w = dag[ch], a = dag[1024 + ch];
        const float kr = k * kk_w; const float n2 = wave_sum(kr * kr); const float kk = kr / fmaxf(sqrtf(n2), 1e-12f);
        const float kp = k * (1.f + (a - 1.f) * ka_w);
        const int o = wid * 64 + lane;
        sR[o] = r; sK[o] = kp; sV[o] = vv; sW[o] = w; sKK[o] = kk; sB[o] = kk * a;
    }
    f32x4 Sa[8], Sb[8];
#pragma unroll
    for (int q = 0; q < 8; ++q) { const float* st = p.in[I_SWKV] + (size_t)(j0 + q) * HD * HD + v * 64 + kq * 8; Sa[q] = __builtin_nontemporal_load((const f32x4*)st); Sb[q] = __builtin_nontemporal_load((const f32x4*)(st + 4)); }
    __syncthreads();
#pragma unroll
    for (int q = 0; q < 8; ++q) {
        const int o = q * 64 + kq * 8;
        const f32x4 w0 = *(const LAS f32x4*)(sW + o), w1 = *(const LAS f32x4*)(sW + o + 4);
        const f32x4 q0 = *(const LAS f32x4*)(sKK + o), q1 = *(const LAS f32x4*)(sKK + o + 4);
        const f32x4 b0 = *(const LAS f32x4*)(sB + o), b1 = *(const LAS f32x4*)(sB + o + 4);
        const f32x4 k0 = *(const LAS f32x4*)(sK + o), k1 = *(const LAS f32x4*)(sK + o + 4);
        const f32x4 r0 = *(const LAS f32x4*)(sR + o), r1 = *(const LAS f32x4*)(sR + o + 4);
        const float vv = sV[q * 64 + v];
        f32x4 A = Sa[q], B = Sb[q];
        float sa = 0.f;
#pragma unroll
        for (int j = 0; j < 4; ++j) { sa += A[j] * q0[j]; sa += B[j] * q1[j]; }
        sa = -red8(sa);
        float y = 0.f;
#pragma unroll
        for (int j = 0; j < 4; ++j) {
            A[j] = A[j] * w0[j] + sa * b0[j] + vv * k0[j];
            B[j] = B[j] * w1[j] + sa * b1[j] + vv * k1[j];
            y += A[j] * r0[j]; y += B[j] * r1[j];
        }
        y = red8(y);
        if (kq == 0) sY[q * 64 + v] = y;
        float* so = p.out + O_WKS + (size_t)(j0 + q) * HD * HD + v * 64 + kq * 8;
        __builtin_nontemporal_store(A, (f32x4*)so); __builtin_nontemporal_store(B, (f32x4*)(so + 4));
    }
    __syncthreads();
    {
        const int o = wid * 64 + lane;
        const float y = sY[o];
        const float mu = wave_sum(y) * (1.f / 64.f); const float d = y - mu; const float var = wave_sum(d * d) * (1.f / 64.f);
        const float yn = d * (1.f / sqrtf(var + GN_EPS)) * gng + gnb;
        const float bonus = wave_sum(sR[o] * sK[o] * rk_w) * sV[o];
        const float g = DAG[(size_t)roww * 3072 + 2048 + ch];
        OMIX[(size_t)roww * D + ch] = f2bf((yn + bonus) * g * beta);
    }
    __syncthreads();
}

__device__ __forceinline__ void conv_item(const Params& p, LAS unsigned char* lds, int it) {
    const int tid = threadIdx.x, lane = tid & 63, wid = tid >> 6;
    const int c = 2 * tid;
    const float* U = (const float*)(p.ws + WS_U); bf16_t* OMIX = (bf16_t*)(p.ws + WS_OMIX);
    const bool samp = it >= 1024;
    const int b = it >> 8, t0 = (it & 255) * 8, s = it - 1024;
    const int row0 = samp ? MP + s : b * SEQ + t0;
    const int ntok = samp ? 1 : 8;
    f32x2 w[CW];
#pragma unroll
    for (int j = 0; j < CW; ++j) w[j] = *(const f32x2*)(p.in[I_CVW] + (size_t)j * DC + c);
    const f32x2 bias = *(const f32x2*)(p.in[I_CVB] + c);
    f32x2 acc[8];
#pragma unroll
    for (int i = 0; i < 8; ++i) acc[i] = bias;
#pragma unroll
    for (int q = 0; q < 38; ++q) {
        f32x2 u = (f32x2){0.f, 0.f};
        if (samp) { if (q < 30) u = __builtin_nontemporal_load((const f32x2*)(p.in[I_SCV] + (size_t)(s * 30 + q) * DC + c)); else if (q == 30) u = *(const f32x2*)(U + (size_t)(MP + s) * DC + c); }
        else { const int t = t0 - 30 + q; if (t >= 0) u = *(const f32x2*)(U + (size_t)(b * SEQ + t) * DC + c); }
#pragma unroll
        for (int i = 0; i < 8; ++i) { const int j = q - i; if (j >= 0 && j < CW) acc[i] += w[j] * u; }
    }
    LAS float* sC = (LAS float*)lds;
#pragma unroll
    for (int i = 0; i < 8; ++i) *(LAS f32x2*)(sC + i * DC + c) = acc[i];
    __syncthreads();
    if (wid < ntok) {
        const LAS f32x4* cr = (const LAS f32x4*)(sC + wid * DC) + lane;
        f32x4 v[4]; float sm = 0.f;
#pragma unroll
        for (int j = 0; j < 4; ++j) { v[j] = cr[64 * j]; sm += (v[j][0] + v[j][1]) + (v[j][2] + v[j][3]); }
        const float mean = wave_sum(sm) * (1.f / DC); float s2 = 0.f;
#pragma unroll
        for (int j = 0; j < 4; ++j) { v[j] = v[j] - mean; s2 += (v[j][0] * v[j][0] + v[j][1] * v[j][1]) + (v[j][2] * v[j][2] + v[j][3] * v[j][3]); }
        const float rstd = 1.f / sqrtf(wave_sum(s2) * (1.f / DC) + LN_EPS);
        bf16_t* orow = OMIX + (size_t)(row0 + wid) * D + DR;
#pragma unroll
        for (int j = 0; j < 4; ++j) {
            const f32x4 gv = ((const f32x4*)p.in[I_CLG])[64 * j + lane], bv = ((const f32x4*)p.in[I_CLB])[64 * j + lane], be = ((const f32x4*)p.in[I_BC])[64 * j + lane];
            f32x4 y = v[j] * rstd * gv + bv;
#pragma unroll
            for (int e = 0; e < 4; ++e) y[e] = y[e] / (1.f + expf(-y[e])) * be[e];
            ((u32x2*)orow)[64 * j + lane] = (u32x2){cvt_pk_bf16(y[0], y[1]), cvt_pk_bf16(y[2], y[3])};
        }
    }
    __syncthreads();
}
constexpr int SBUF = 6 * TC * 64;
struct ProdRegs { float c[8][3], q0[3], w[8], a[8]; };
__device__ __forceinline__ void prod_load(const Params& p, ProdRegs& R, int row0, int h, int pw, int lane) {
    const float* DAG = (const float*)(p.ws + WS_RB);
    const int ch = h * 64 + lane;
#pragma unroll
    for (int i = 0; i < 8; ++i) {
        const int s = pw * 8 + i;
        const float* dag = DAG + (size_t)(row0 + s) * 3072;
        load_rkv_cur(p, row0 + s, ch, R.c[i]);
        R.w[i] = dag[ch]; R.a[i] = dag[1024 + ch];
    }
    load_rkv_prev(p, row0 + pw * 8, ch, R.q0);
}
__device__ __forceinline__ void prod_store(const ProdRegs& R, LAS float* buf, int row0, int pw, int lane, float kk_w, float ka_w, float mu_r, float mu_k, float mu_v) {
#pragma unroll
    for (int i = 0; i < 8; ++i) {
        const int s = pw * 8 + i;
        const bool zp = (i == 0) && (((row0 + s) & (SEQ - 1)) == 0);
        const float qr = i ? R.c[i ? i - 1 : 0][0] : R.q0[0], qk = i ? R.c[i ? i - 1 : 0][1] : R.q0[1], qv = i ? R.c[i ? i - 1 : 0][2] : R.q0[2];
        const float r = shift_mix(R.c[i][0], qr, mu_r, zp), k = shift_mix(R.c[i][1], qk, mu_k, zp), vv = shift_mix(R.c[i][2], qv, mu_v, zp);
        const float kr = k * kk_w; const float n2 = wave_sum(kr * kr); const float kk = kr * __builtin_amdgcn_rsqf(fmaxf(n2, 1e-24f));
        const float kp = k * (1.f + (R.a[i] - 1.f) * ka_w);
        const int o = s * 64 + lane;
        buf[o] = r; buf[TC * 64 + o] = kp; buf[2 * TC * 64 + o] = vv; buf[3 * TC * 64 + o] = R.w[i]; buf[4 * TC * 64 + o] = kk; buf[5 * TC * 64 + o] = kk * R.a[i];
    }
}
struct StepRegs { f32x4 r4, k4, w4, q4, b4; float vv; };
__device__ __forceinline__ void step_load(StepRegs& T, const LAS float* pb, const LAS float* pv, int s) {
    T.r4 = *(const LAS f32x4*)(pb + s * 64); T.k4 = *(const LAS f32x4*)(pb + TC * 64 + s * 64); T.w4 = *(const LAS f32x4*)(pb + 3 * TC * 64 + s * 64);
    T.q4 = *(const LAS f32x4*)(pb + 4 * TC * 64 + s * 64); T.b4 = *(const LAS f32x4*)(pb + 5 * TC * 64 + s * 64); T.vv = pv[s * 64];
}
__device__ __forceinline__ f32x2 lo2(const f32x4& a) { return __builtin_shufflevector(a, a, 0, 1); }
__device__ __forceinline__ f32x2 hi2(const f32x4& a) { return __builtin_shufflevector(a, a, 2, 3); }
__device__ __forceinline__ void red16x2(float& a, float& b) {
    a += dppf<0xB1>(a); b += dppf<0xB1>(b); a += dppf<0x4E>(a); b += dppf<0x4E>(b);
    a += dppf<0x141>(a); b += dppf<0x141>(b); a += dppf<0x140>(a); b += dppf<0x140>(b);
}
template <bool STORE>
__device__ __forceinline__ void step_compute(const StepRegs& T, const f32x4& rprev, f32x2& S01, f32x2& S23, float* yprev) {
    const f32x2 vv2 = (f32x2){T.vv, T.vv};
    const f32x2 t01 = S01 * lo2(T.w4) + vv2 * lo2(T.k4), t23 = S23 * hi2(T.w4) + vv2 * hi2(T.k4);
    const f32x2 dv = S23 * hi2(T.q4) + S01 * lo2(T.q4);
    const f32x2 ev = S23 * hi2(rprev) + S01 * lo2(rprev);
    float d = dv[0] + dv[1], e = ev[0] + ev[1];
    red16x2(d, e);
    if (STORE) *yprev = e;
    const f32x2 d2 = (f32x2){d, d};
    S01 = t01 - d2 * lo2(T.b4); S23 = t23 - d2 * hi2(T.b4);
}
__device__ __forceinline__ void scan_consume(const LAS float* buf, f32x2& S01, f32x2& S23, int v, int kq, float* Yp) {
    const LAS float* pb = buf + kq * 4; const LAS float* pv = buf + 2 * TC * 64 + v;
    StepRegs A, B;
    step_load(A, pb, pv, 0);
    step_load(B, pb, pv, 1);
    step_compute<false>(A, A.r4, S01, S23, Yp);
#pragma unroll
    for (int s = 1; s < TC; s += 2) {
        const f32x4 rA = A.r4;
        if (s + 1 < TC) step_load(A, pb, pv, s + 1);
        step_compute<true>(B, rA, S01, S23, Yp + (size_t)(s - 1) * 1024);
        if (s + 1 < TC) {
            const f32x4 rB = B.r4;
            if (s + 2 < TC) step_load(B, pb, pv, s + 2);
            step_compute<true>(A, rB, S01, S23, Yp + (size_t)s * 1024);
        }
    }
    { const f32x2 ev = S23 * hi2(B.r4) + S01 * lo2(B.r4); Yp[(size_t)(TC - 1) * 1024] = red16(ev[0] + ev[1]); }
}
__device__ __forceinline__ void phase_scan(const Params& p, LAS unsigned char* lds, int G, int bid) {
    const int tid = threadIdx.x, lane = tid & 63, wid = __builtin_amdgcn_readfirstlane(tid >> 6);
    LAS float* buf0 = (LAS float*)lds; LAS float* buf1 = buf0 + SBUF;
    float* Y = (float*)(p.ws + WS_Y);
    constexpr int NCH = SEQ / TC;
    for (int item = bid; item < NB * NH * 4; item += G) {
        const int bh = item >> 2, qd = item & 3, b = bh >> 4, h = bh & 15, row0 = b * SEQ;
        const int ch = h * 64 + lane;
        const float kk_w = p.in[I_KK][ch], ka_w = p.in[I_KA][ch], mu_r = p.in[I_MU][ch], mu_k = p.in[I_MU][1024 + ch], mu_v = p.in[I_MU][2048 + ch];
        f32x2 S01 = (f32x2){0.f, 0.f}, S23 = (f32x2){0.f, 0.f};
        const int v = qd * 16 + (wid & 3) * 4 + (lane >> 4), kq = lane & 15;
        ProdRegs R;
        if (wid >= 4) { prod_load(p, R, row0, h, wid - 4, lane); prod_store(R, buf0, row0, wid - 4, lane, kk_w, ka_w, mu_r, mu_k, mu_v); prod_load(p, R, row0 + TC, h, wid - 4, lane); }
        asm volatile("s_waitcnt lgkmcnt(0)" ::: "memory"); __builtin_amdgcn_s_barrier(); asm volatile("" ::: "memory");
#pragma unroll 1
        for (int c = 0; c < NCH; ++c) {
            LAS float* cb = (c & 1) ? buf1 : buf0; LAS float* nb = (c & 1) ? buf0 : buf1;
            if (wid < 4) scan_consume(cb, S01, S23, v, kq, Y + (size_t)(row0 + c * TC) * 1024 + h * 64 + v);
            else {
                if (c + 1 < NCH) prod_store(R, nb, row0 + (c + 1) * TC, wid - 4, lane, kk_w, ka_w, mu_r, mu_k, mu_v);
                if (c + 2 < NCH) prod_load(p, R, row0 + (c + 2) * TC, h, wid - 4, lane);
            }
            asm volatile("s_waitcnt lgkmcnt(0)" ::: "memory"); __builtin_amdgcn_s_barrier(); asm volatile("" ::: "memory");
        }
        if (wid < 4) *(f32x4*)(p.out + O_WKP + (size_t)bh * HD * HD + v * 64 + kq * 4) = (f32x4){S01[0], S01[1], S23[0], S23[1]};
    }
}
__device__ __forceinline__ void phase_mix2(const Params& p, LAS unsigned char* lds, int G, int bid) {
    const int tid = threadIdx.x, lane = tid & 63, wid = tid >> 6;
    {
        const float* DAG = (const float*)(p.ws + WS_RB); const float* Y = (const float*)(p.ws + WS_Y); bf16_t* OMIX = (bf16_t*)(p.ws + WS_OMIX);
        const int gw = bid * 8 + wid, NGW = G * 8;
        const int h = gw & 15, ch = h * 64 + lane;
        const float ka_w = p.in[I_KA][ch], rk_w = p.in[I_RK][ch], gng = p.in[I_GNG][ch], gnb = p.in[I_GNB][ch], beta = p.in[I_BR][ch];
        const float mu_r = p.in[I_MU][ch], mu_k = p.in[I_MU][1024 + ch], mu_v = p.in[I_MU][2048 + ch];
        const int rstep = NGW >> 4;
        for (int grp = gw >> 4; grp < MP / 4; grp += rstep) {
            const int rb = grp * 4;
            float y[4], cc[4][3], q0[3], a[4], g[4];
#pragma unroll
            for (int u = 0; u < 4; ++u) {
                const int row = rb + u; const float* dag = DAG + (size_t)row * 3072;
                load_rkv_cur(p, row, ch, cc[u]); y[u] = Y[(size_t)row * 1024 + ch]; a[u] = dag[1024 + ch]; g[u] = dag[2048 + ch];
            }
            load_rkv_prev(p, rb, ch, q0);
#pragma unroll
            for (int u = 0; u < 4; ++u) {
                const int row = rb + u;
                const bool zp = (u == 0) && ((row & (SEQ - 1)) == 0);
                const float qr = u ? cc[u ? u - 1 : 0][0] : q0[0], qk = u ? cc[u ? u - 1 : 0][1] : q0[1], qv = u ? cc[u ? u - 1 : 0][2] : q0[2];
                const float r = shift_mix(cc[u][0], qr, mu_r, zp), k = shift_mix(cc[u][1], qk, mu_k, zp), vv = shift_mix(cc[u][2], qv, mu_v, zp);
                const float kp = k * (1.f + (a[u] - 1.f) * ka_w);
                const float mu = wave_sum(y[u]) * (1.f / 64.f); const float d = y[u] - mu; const float var = wave_sum(d * d) * (1.f / 64.f);
                const float yn = d * (1.f / sqrtf(var + GN_EPS)) * gng + gnb;
                const float bonus = wave_sum(r * kp * rk_w) * vv;
                OMIX[(size_t)row * D + ch] = f2bf((yn + bonus) * g[u] * beta);
            }
        }
    }
    constexpr int NCONV = 1024 + MS, NSAMP8 = MS * NH / 8;
    for (int it = bid; it < NCONV + NSAMP8; it += G) {
        if (it < NCONV) conv_item(p, lds, it);
        else rwkv_sample8(p, lds, (it - NCONV) * 8);
    }
}

__device__ __forceinline__ void samp_attn_item(const Params& p, LAS unsigned char* lds, int it) {
    const int tid = threadIdx.x, lane = tid & 63, wid = tid >> 6;
    const int s = it >> 2, h = it & 3;
    bf16_t* OA = (bf16_t*)(p.ws + WS_OA) + (size_t)(MP + s) * D + h * MHD;
    LAS float* sS = (LAS float*)lds;
    LAS float* sO = sS + 256;
    float q[8];
    { const float* PART = (const float*)(p.ws + WS_PART) + (size_t)s * D + h * MHD;
      f32x4 a = (f32x4){0.f, 0.f, 0.f, 0.f}, b = a;
#pragma unroll
      for (int sl = 0; sl < 8; ++sl) { a += *(const f32x4*)(PART + (size_t)sl * 128 * D + lane * 4); b += *(const f32x4*)(PART + (size_t)sl * 128 * D + 256 + lane * 4); }
#pragma unroll
      for (int j = 0; j < 4; ++j) { q[j] = a[j] * QSCALE; q[4 + j] = b[j] * QSCALE; } }
    const float* Kc = p.in[I_CK] + ((size_t)s * NMEM * NMH + h) * MHD;
    const float* Vc = p.in[I_CV] + ((size_t)s * NMEM * NMH + h) * MHD;
#pragma unroll 1
    for (int kb = 0; kb < 32; kb += 4) {
        f32x4 ka[4], kb4[4];
#pragma unroll
        for (int u = 0; u < 4; ++u) { const float* kr = Kc + (size_t)(wid * 32 + kb + u) * D; ka[u] = __builtin_nontemporal_load((const f32x4*)(kr + lane * 4)); kb4[u] = __builtin_nontemporal_load((const f32x4*)(kr + 256 + lane * 4)); }
#pragma unroll
        for (int u = 0; u < 4; ++u) {
            float d = ka[u][0] * q[0] + ka[u][1] * q[1] + ka[u][2] * q[2] + ka[u][3] * q[3] + kb4[u][0] * q[4] + kb4[u][1] * q[5] + kb4[u][2] * q[6] + kb4[u][3] * q[7];
            d = wave_sum(d);
            if (lane == 0) sS[wid * 32 + kb + u] = d;
        }
    }
    __syncthreads();
    {
        const float s0 = sS[lane], s1 = sS[lane + 64], s2 = sS[lane + 128], s3 = sS[lane + 192];
        const float mx = wave_max(fmaxf(fmaxf(s0, s1), fmaxf(s2, s3)));
        const float e0 = __expf(s0 - mx), e1 = __expf(s1 - mx), e2 = __expf(s2 - mx), e3 = __expf(s3 - mx);
        const float inv = 1.f / wave_sum((e0 + e1) + (e2 + e3));
        __syncthreads();
        if (wid == 0) { sS[lane] = e0 * inv; sS[lane + 64] = e1 * inv; sS[lane + 128] = e2 * inv; sS[lane + 192] = e3 * inv; }
    }
    __syncthreads();
    {
        const int g = tid >> 7, d4 = tid & 127;
        f32x4 o = (f32x4){0.f, 0.f, 0.f, 0.f};
#pragma unroll 1
        for (int kb = 0; kb < 64; kb += 8) {
            f32x4 vv[8];
#pragma unroll
            for (int u = 0; u < 8; ++u) vv[u] = __builtin_nontemporal_load((const f32x4*)(Vc + (size_t)(g * 64 + kb + u) * D + d4 * 4));
#pragma unroll
            for (int u = 0; u < 8; ++u) o += vv[u] * sS[g * 64 + kb + u];
        }
        *(LAS f32x4*)(sO + g * 512 + d4 * 4) = o;
    }
    __syncthreads();
    if (tid < 128) {
        const f32x4 o = (*(const LAS f32x4*)(sO + tid * 4) + *(const LAS f32x4*)(sO + 512 + tid * 4)) + (*(const LAS f32x4*)(sO + 1024 + tid * 4) + *(const LAS f32x4*)(sO + 1536 + tid * 4));
        *(u32x2*)(OA + tid * 4) = (u32x2){cvt_pk_bf16(o[0], o[1]), cvt_pk_bf16(o[2], o[3])};
    }
    __syncthreads();
}

#define XB_TMO      128
#define XB_XCNT(j)  (256  + 64 * (j))
#define XB_XSUB(j)  (1280 + 64 * (j))
#define XB_XGEN(j)  (2304 + 64 * (j))
#define XB_TOP      3328
#define XB_TOPGEN   3392
#define XCD_BAR_WORDS 3456
#define XB_SPIN_CAP (1u << 18)
__device__ __forceinline__ unsigned xb_ld(unsigned* p)              { return __hip_atomic_load(p, __ATOMIC_RELAXED, __HIP_MEMORY_SCOPE_AGENT); }
__device__ __forceinline__ unsigned xb_add(unsigned* p, unsigned v) { return __hip_atomic_fetch_add(p, v, __ATOMIC_RELAXED, __HIP_MEMORY_SCOPE_AGENT); }
__device__ __forceinline__ unsigned xb_xcc_id() { return (unsigned)__builtin_amdgcn_s_getreg((3 << 11) | 20) & 0xFu; }
#define XB_SPIN(cond, bar) do { unsigned _sp = 0; while (cond) { __builtin_amdgcn_s_sleep(1); \
    if ((++_sp & 255u) == 0u) { if (xb_ld(&(bar)[XB_TMO])) break; if (_sp > XB_SPIN_CAP) { atomicAdd(&(bar)[XB_TMO], 1u); break; } } } } while (0)
struct XcdBarrier { unsigned* bar; unsigned x; volatile LAS unsigned* st; };
__device__ __forceinline__ XcdBarrier xcd_barrier_post(unsigned* bar, volatile LAS unsigned* st) {
    XcdBarrier b; b.bar = bar; b.x = xb_xcc_id(); b.st = st;
    if (threadIdx.x == 0) (void)xb_add(&bar[XB_XCNT(b.x)], 1u);
    return b;
}
__device__ __forceinline__ void xcd_barrier_complete(unsigned* bar, unsigned x, unsigned& nloc, unsigned& nx) {
    const unsigned G = gridDim.x * gridDim.y * gridDim.z;
    unsigned sum, cnt, mine, sp = 0u;
    for (;;) {
        sum = 0u; cnt = 0u; mine = 0u;
#pragma unroll
        for (unsigned j = 0; j < 16; ++j) { const unsigned c = xb_ld(&bar[XB_XCNT(j)]); sum += c; cnt += (c > 0u) ? 1u : 0u; mine = (j == x) ? c : mine; }
        if (sum == G) break;
        __builtin_amdgcn_s_sleep(1);
        if ((++sp & 255u) == 0u) { if (xb_ld(&bar[XB_TMO])) break; if (sp > XB_SPIN_CAP) { atomicAdd(&bar[XB_TMO], 1u); break; } }
    }
    nloc = mine > 0u ? mine : 1u; nx = cnt > 0u ? cnt : 1u;
}
__device__ __forceinline__ void xcd_barrier(const XcdBarrier& b) {
    asm volatile("s_waitcnt vmcnt(0)" ::: "memory");
    __syncthreads();
    if (threadIdx.x == 0) {
        unsigned* bar = b.bar;
        __builtin_amdgcn_s_waitcnt(0);
        unsigned nloc = b.st[0], nx = b.st[1];
        if (nloc == 0u) { xcd_barrier_complete(bar, b.x, nloc, nx); b.st[0] = nloc; b.st[1] = nx; }
        const unsigned old = xb_add(&bar[XB_XSUB(b.x)], 1u);
        const unsigned gen = old / nloc;
        if (old + 1u == (gen + 1u) * nloc) {
            __builtin_amdgcn_fence(__ATOMIC_RELEASE, "agent");
            asm volatile("s_waitcnt vmcnt(0)" ::: "memory");
            const unsigned og = xb_add(&bar[XB_TOP], 1u);
            const unsigned tg = og / nx;
            if (og + 1u == (tg + 1u) * nx) xb_add(&bar[XB_TOPGEN], 1u);
            else XB_SPIN(xb_ld(&bar[XB_TOPGEN]) == tg, bar);
            __builtin_amdgcn_fence(__ATOMIC_ACQUIRE, "agent");
            xb_add(&bar[XB_XGEN(b.x)], 1u);
            asm volatile("s_waitcnt vmcnt(0)" ::: "memory");
        } else {
            XB_SPIN(xb_ld(&bar[XB_XGEN(b.x)]) == gen, bar);
            __builtin_amdgcn_fence(__ATOMIC_ACQUIRE, "agent");
            asm volatile("s_waitcnt vmcnt(0)" ::: "memory");
        }
    }
    __syncthreads();
}

__global__ void __launch_bounds__(512, 2) fwd_megakernel(Params p) {
    extern __shared__ __attribute__((aligned(16))) unsigned char lds_raw[];
    LAS unsigned char* lds = (LAS unsigned char*)lds_raw;
    cg::grid_group grid = cg::this_grid();
    const int G = gridDim.x, bid = blockIdx.x;
    unsigned char* ws = p.ws;
    const int lo = p.ph_lo, hi = p.ph_hi;
#define IN(k) (lo <= (k) && (k) < hi)
    volatile LAS unsigned* bst = (volatile LAS unsigned*)(lds + 131072);
    if (threadIdx.x < 2) bst[threadIdx.x] = 0u;
    __syncthreads();
    XcdBarrier xbar = xcd_barrier_post((unsigned*)(ws + WS_CTL), bst);
    if (p.ph_hi < 0) grid.sync();
#define SEAM(k) do { if (IN(k) && IN((k) + 1)) xcd_barrier(xbar); } while (0)
#define EXTRA_SYNC() xcd_barrier(xbar)
    bf16_t* XB = (bf16_t*)(ws + WS_XB); bf16_t* Z = (bf16_t*)(ws + WS_Z); float* XF = (float*)(ws + WS_XF);
    bf16_t* Hb = (bf16_t*)(ws + WS_RB);

    float* PART = (float*)(ws + WS_PART);
    if (IN(0)) { for (int _r = 0; _r <= ((DUPMASK >> 0) & 1); ++_r) { phase_prep(p, lds, G, bid);  if (_r < ((DUPMASK >> 0) & 1)) EXTRA_SYNC(); } } SEAM(0);
    if (IN(1)) { for (int _r = 0; _r <= ((DUPMASK >> 1) & 1); ++_r) {
        { SchedPlain S; S.init(XB, ws + WS_W13A, D, D, 33, 44, G, bid); EpiGluH E{Hb}; gemm_phase(lds, D, D, D, S, E); }
        { SchedPlain S; S.init(ws + WS_MEMB, ws + WS_WMK, D, D, 4, 16, G, G - 1 - bid); EpiMemKV E{p.out + O_MKP, p.out + O_MVP, (bf16_t*)(ws + WS_KB), (bf16_t*)(ws + WS_VT)}; gemm_phase(lds, D, D, D, S, E); }
     if (_r < ((DUPMASK >> 1) & 1)) EXTRA_SYNC(); } } SEAM(1);
    if (IN(2)) { for (int _r = 0; _r <= ((DUPMASK >> 2) & 1); ++_r) {
        { SchedPlain S; S.init(Hb, ws + WS_W2A, FF, FF, 32, 8, G, bid); EpiResidB E{Z, XB, 0.5f}; gemm_phase(lds, FF, FF, FF, S, E); }
        { SchedPieces S{(const char*)Hb, (const char*)(ws + WS_W2A), FF, FF, 8 * 22, G, bid}; EpiPart E{PART}; gemm_phase(lds, FF, FF, 256, S, E); }
     if (_r < ((DUPMASK >> 2) & 1)) EXTRA_SYNC(); } } SEAM(2);
    if (IN(3)) { for (int _r = 0; _r <= ((DUPMASK >> 3) & 1); ++_r) { phase_ln(lds, Z, p.in[I_LN1G], p.in[I_LN1B], nullptr, XB, G, bid, PART, 22, p.in[I_XS], nullptr, 0.5f);  if (_r < ((DUPMASK >> 3) & 1)) EXTRA_SYNC(); } } SEAM(3);
    if (IN(4)) { for (int _r = 0; _r <= ((DUPMASK >> 4) & 1); ++_r) {
        SchedPlain S; S.init(XB, ws + WS_WIN, D, D, 33, 22, G, bid); EpiWin E{(float*)(ws + WS_RA), (float*)(ws + WS_U)}; gemm_phase(lds, D, D, D, S, E);
     if (_r < ((DUPMASK >> 4) & 1)) EXTRA_SYNC(); } } SEAM(4);
    if (IN(5)) { for (int _r = 0; _r <= ((DUPMASK >> 5) & 1); ++_r) { phase_mixpre(p, G, bid);  if (_r < ((DUPMASK >> 5) & 1)) EXTRA_SYNC(); } } SEAM(5);
    if (IN(6)) { for (int _r = 0; _r <= ((DUPMASK >> 6) & 1); ++_r) {
        SchedPlain S; S.init(ws + WS_LA, ws + WS_WLORA, LK, LK, 33, 12, G, bid); EpiLora E{(float*)(ws + WS_RB), p.in[I_W0], p.in[I_A0]}; gemm_phase(lds, LK, LK, LK, S, E);
     if (_r < ((DUPMASK >> 6) & 1)) EXTRA_SYNC(); } } SEAM(6);
    if (IN(7)) { for (int _r = 0; _r <= ((DUPMASK >> 7) & 1); ++_r) { phase_scan(p, lds, G, bid);  if (_r < ((DUPMASK >> 7) & 1)) EXTRA_SYNC(); } } SEAM(7);
    if (IN(8)) { for (int _r = 0; _r <= ((DUPMASK >> 8) & 1); ++_r) { phase_mix2(p, lds, G, bid);  if (_r < ((DUPMASK >> 8) & 1)) EXTRA_SYNC(); } } SEAM(8);
    if (IN(9)) { for (int _r = 0; _r <= ((DUPMASK >> 9) & 1); ++_r) {
        { SchedPlain S; S.init(ws + WS_OMIX, ws + WS_WOUT, D, D, 32, 8, G, bid); EpiResidB E{Z, XB, 1.0f}; gemm_phase(lds, D, D, D, S, E); }
        { SchedPieces S{(const char*)(ws + WS_OMIX), (const char*)(ws + WS_WOUT), D, D, 8 * 8, G, bid}; EpiPart E{PART}; gemm_phase(lds, D, D, 256, S, E); }
     if (_r < ((DUPMASK >> 9) & 1)) EXTRA_SYNC(); } } SEAM(9);
    if (IN(10)) { for (int _r = 0; _r <= ((DUPMASK >> 10) & 1); ++_r) { phase_ln(lds, Z, p.in[I_LN2G], p.in[I_LN2B], nullptr, XB, G, bid, PART, 8, nullptr, XB + (size_t)MP * D, 1.0f);  if (_r < ((DUPMASK >> 10) & 1)) EXTRA_SYNC(); } } SEAM(10);
    if (IN(11)) { for (int _r = 0; _r <= ((DUPMASK >> 11) & 1); ++_r) {
        { SchedPlain S; S.init(XB, ws + WS_WMQ, D, D, 32, 8, G, bid); EpiBf16 E{(bf16_t*)(ws + WS_Q), D, QSCALE, MP}; gemm_phase(lds, D, D, D, S, E); }
        { SchedPieces S{(const char*)XB, (const char*)(ws + WS_WMQ), D, D, 8 * 8, G, bid}; EpiPart E{PART}; gemm_phase(lds, D, D, 256, S, E); }
     if (_r < ((DUPMASK >> 11) & 1)) EXTRA_SYNC(); } } SEAM(11);
    if (IN(12)) { for (int _r = 0; _r <= ((DUPMASK >> 12) & 1); ++_r) {
        { SchedScores S{(const char*)(ws + WS_Q), (const char*)(ws + WS_KB), G, bid}; EpiSoftmax E{(bf16_t*)(ws + WS_P)}; gemm_phase(lds, D, D, MHD, S, E); }
        for (int it = bid; it < MS * NMH; it += G) samp_attn_item(p, lds, it);
     if (_r < ((DUPMASK >> 12) & 1)) EXTRA_SYNC(); } } SEAM(12);
    if (IN(13)) { for (int _r = 0; _r <= ((DUPMASK >> 13) & 1); ++_r) {
        SchedPV S{(const char*)(ws + WS_P), (const char*)(ws + WS_VT), G, bid}; EpiBf16 E{(bf16_t*)(ws + WS_OA), D, 1.0f, MP}; gemm_phase(lds, 1024, NMEM, NMEM, S, E);
     if (_r < ((DUPMASK >> 13) & 1)) EXTRA_SYNC(); } } SEAM(13);
    if (IN(14)) { for (int _r = 0; _r <= ((DUPMASK >> 14) & 1); ++_r) {
        { SchedPlain S; S.init(ws + WS_OA, ws + WS_WMO, D, D, 32, 8, G, bid); EpiResidB E{Z, XB, 1.0f}; gemm_phase(lds, D, D, D, S, E); }
        { SchedPieces S{(const char*)(ws + WS_OA), (const char*)(ws + WS_WMO), D, D, 8 * 8, G, bid}; EpiPart E{PART}; gemm_phase(lds, D, D, 256, S, E); }
     if (_r < ((DUPMASK >> 14) & 1)) EXTRA_SYNC(); } } SEAM(14);
    if (IN(15)) { for (int _r = 0; _r <= ((DUPMASK >> 15) & 1); ++_r) { phase_ln(lds, Z, p.in[I_LN3G], p.in[I_LN3B], nullptr, XB, G, bid, PART, 8, nullptr, XB + (size_t)MP * D, 1.0f);  if (_r < ((DUPMASK >> 15) & 1)) EXTRA_SYNC(); } } SEAM(15);
    if (IN(16)) { for (int _r = 0; _r <= ((DUPMASK >> 16) & 1); ++_r) {
        SchedPlain S; S.init(XB, ws + WS_W13B, D, D, 33, 44, G, bid); EpiGluH E{Hb}; gemm_phase(lds, D, D, D, S, E);
     if (_r < ((DUPMASK >> 16) & 1)) EXTRA_SYNC(); } } SEAM(16);
    if (IN(17)) { for (int _r = 0; _r <= ((DUPMASK >> 17) & 1); ++_r) {
        { SchedPlain S; S.init(Hb, ws + WS_W2B, FF, FF, 32, 8, G, bid); EpiResidB E{Z, XB, 0.5f}; gemm_phase(lds, FF, FF, FF, S, E); }
        { SchedPieces S{(const char*)Hb, (const char*)(ws + WS_W2B), FF, FF, 8 * 22, G, bid}; EpiPart E{PART}; gemm_phase(lds, FF, FF, 256, S, E); }
     if (_r < ((DUPMASK >> 17) & 1)) EXTRA_SYNC(); } } SEAM(17);
    if (IN(18)) for (int _r = 0; _r <= ((DUPMASK >> 18) & 1); ++_r) { if (_r) EXTRA_SYNC(); phase_ln(lds, Z, p.in[I_LN4G], p.in[I_LN4B], p.out + O_Y, nullptr, G, bid, PART, 22, nullptr, XB + (size_t)MP * D, 0.5f); }
#undef IN
#undef SEAM
}

extern "C" void kernel_launch(void* const* d_in, const int* in_sizes, int n_in, void* d_out, int out_size, void* d_ws, size_t ws_size, hipStream_t stream) {
    static int grid = 0;
    if (grid == 0) {
        if (n_in != N_IN || (size_t)out_size != O_END || ws_size < WS_END) { fprintf(stderr, "kernel_launch: unexpected shapes: n_in %d out %d ws %zu (need %zu)\n", n_in, out_size, ws_size, (size_t)WS_END); grid = -1; return; }
        int dev = 0, cus = 0, per_cu = 0;
        if (hipGetDevice(&dev) != hipSuccess || hipDeviceGetAttribute(&cus, hipDeviceAttributeMultiprocessorCount, dev) != hipSuccess) { fprintf(stderr, "kernel_launch: device query failed\n"); grid = -1; return; }
        if (hipFuncSetAttribute((const void*)fwd_megakernel, hipFuncAttributeMaxDynamicSharedMemorySize, LDS_BYTES) != hipSuccess) { fprintf(stderr, "kernel_launch: hipFuncSetAttribute failed\n"); grid = -1; return; }
        if (hipOccupancyMaxActiveBlocksPerMultiprocessor(&per_cu, (const void*)fwd_megakernel, 512, LDS_BYTES) != hipSuccess || per_cu < 1) { fprintf(stderr, "kernel_launch: occupancy query gives %d\n", per_cu); (void)hipGetLastError(); per_cu = 1; }
        grid = cus * 1;
        if (grid < 128) { fprintf(stderr, "kernel_launch: grid %d too small\n", grid); grid = -1; return; }
    }
    if (grid < 0) return;
    Params p{};
    for (int i = 0; i < N_IN; ++i) p.in[i] = (const float*)d_in[i];
    p.out = (float*)d_out; p.ws = (unsigned char*)d_ws; p.ph_lo = 0; p.ph_hi = NPHASE;
    if (hipMemsetAsync((char*)d_ws + WS_CTL, 0, 16384, stream) != hipSuccess) { fprintf(stderr, "kernel_launch: memset of the barrier words failed\n"); return; }
    void* args[] = {&p};
    hipError_t e = hipLaunchCooperativeKernel((const void*)fwd_megakernel, dim3(grid), dim3(512), args, LDS_BYTES, stream);
    if (e != hipSuccess) fprintf(stderr, "cooperative launch failed: %s (grid %d)\n", hipGetErrorString(e), grid);
}
```
